# Optimizing an MI355X kernel written in HIP

```python
import math
import jax, jax.numpy as jnp
from jax import lax
import numpy as np

D_MODEL = 1024
BATCH = 16
SEQ = 256
DEPTH = 2
DEC_BATCH = 4
DEC_SEQ = 2048
PAST_LEN = 512

GRID_W = 64
EPS = 1e-6
N_MOD = 6
CHUNK = 128
A_GROUPS = 4
A_GROUP_W = 128
A_WIDTH = A_GROUPS * A_GROUP_W
LRU_BLOCKS = 8
LRU_BLOCK_W = 64
LRU_WIDTH = LRU_BLOCKS * LRU_BLOCK_W
CONV_W = 4
LRU_C = 8.0
ATT_HEADS = 4
ATT_HD = 64
ATT_VD = 2 * ATT_HD
ATT_WIDTH = ATT_HEADS * ATT_VD
Q_BLOCK = 128
ROPE_BASE = 10000.0
ROPE_AXIS_DIM = ATT_HD // 2
ROPE_FREQS = ROPE_AXIS_DIM // 2
N_BRANCH = 3
IN_SPLITS = (A_WIDTH, 2 * A_WIDTH, 2 * A_WIDTH + LRU_WIDTH, 2 * A_WIDTH + 2 * LRU_WIDTH,
             2 * A_WIDTH + 2 * LRU_WIDTH + ATT_WIDTH, 2 * A_WIDTH + 2 * LRU_WIDTH + 2 * ATT_WIDTH,
             2 * A_WIDTH + 2 * LRU_WIDTH + 3 * ATT_WIDTH)
IN_WIDTH = IN_SPLITS[-1] + N_BRANCH * D_MODEL
PEER_HEADS = 8
N_KEYS = 128
N_EXPERTS = N_KEYS * N_KEYS
PEER_QDIM = 256
PEER_HALF = PEER_QDIM // 2
PEER_TOPK = 16
TOKEN_BLOCK = 128

kernel_name = 'hybrid_diffusion_step_gmlp_rglru_diffattn_peer'


def rmsnorm(x, gain):
    xf = x.astype(jnp.float32)
    y = xf * lax.rsqrt(jnp.mean(xf * xf, axis=-1, keepdims=True) + EPS)
    return (y * gain.astype(jnp.float32)).astype(x.dtype)


def axial_rope_tables(rows):
    row_ids = jnp.repeat(jnp.arange(rows), GRID_W).astype(jnp.float32)
    col_ids = jnp.tile(jnp.arange(GRID_W), rows).astype(jnp.float32)
    inv_freq = ROPE_BASE ** (-jnp.arange(ROPE_FREQS, dtype=jnp.float32) / ROPE_FREQS)
    ang_r = (row_ids[:, None] * inv_freq)[:, None, None, :]
    ang_c = (col_ids[:, None] * inv_freq)[:, None, None, :]
    return (jnp.cos(ang_r), jnp.sin(ang_r), jnp.cos(ang_c), jnp.sin(ang_c))


def rotate(x, cos, sin):
    x1, x2 = x[..., :ROPE_FREQS], x[..., ROPE_FREQS:]
    return jnp.concatenate([x1 * cos - x2 * sin, x1 * sin + x2 * cos], axis=-1)


def apply_axial_rope(x, tabs):
    cos_r, sin_r, cos_c, sin_c = tabs
    xf = x.astype(jnp.float32)
    out = jnp.concatenate([rotate(xf[..., :ROPE_AXIS_DIM], cos_r, sin_r),
                           rotate(xf[..., ROPE_AXIS_DIM:], cos_c, sin_c)], axis=-1)
    return out.astype(x.dtype)


def chunk_mlp(u, v, g_v, w_s, b_s):
    b, s, _ = u.shape
    vn = rmsnorm(v, g_v).reshape(b, s // CHUNK, CHUNK, A_GROUPS, A_GROUP_W)
    mixed = jnp.einsum('gpq,bnqgc->bnpgc', w_s, vn) + b_s.T[None, None, :, :, None]
    return u * mixed.reshape(b, s, A_WIDTH)


def centred_conv(x, w, bias):
    s = x.shape[1]
    left = CONV_W // 2
    xp = jnp.pad(x, ((0, 0), (left, CONV_W - 1 - left), (0, 0)))
    return sum(xp[:, j:j + s] * w[j] for j in range(CONV_W)) + bias


def blockdiag(x, w):
    xb = x.reshape(x.shape[:-1] + (LRU_BLOCKS, LRU_BLOCK_W))
    return jnp.einsum('bshi,hij->bshj', xb, w).reshape(x.shape)


def linear_scan(a, bx, h0):
    def combine(left, right):
        a_l, b_l = left
        a_r, b_r = right
        return a_l * a_r, a_r * b_l + b_r
    a_cum, b_cum = lax.associative_scan(combine, (a, bx), axis=1)
    return a_cum * h0[:, None, :] + b_cum


def lru_direction(xc, p, d, h0):
    xf = xc.astype(jnp.float32)
    r = jax.nn.sigmoid(blockdiag(xf, p['lru_w_r'][d]) + p['lru_b_r'][d])
    i = jax.nn.sigmoid(blockdiag(xf, p['lru_w_i'][d]) + p['lru_b_i'][d])
    log_a = -LRU_C * r * jax.nn.softplus(-p['lru_lam'][d].astype(jnp.float32))
    bx = jnp.sqrt(-jnp.expm1(2.0 * log_a)) * (i * xf)
    hs = linear_scan(jnp.exp(log_a), bx, h0.astype(jnp.float32))
    return hs, hs[:, -1]


def diff_attention(q, k, v, lam):
    b, sq, h = q.shape[0], q.shape[1], q.shape[2]
    nb = sq // Q_BLOCK
    qb = q.reshape(b, nb, Q_BLOCK, h, 2, ATT_HD).transpose(1, 0, 2, 3, 4, 5)
    scale = ATT_HD ** -0.5

    def one_block(qblk):
        s = jnp.einsum('bqhtd,bkhtd->bhtqk', qblk, k).astype(jnp.float32) * scale
        prob = jax.nn.softmax(s, axis=-1)
        w = prob[:, :, 0] - lam * prob[:, :, 1]
        return jnp.einsum('bhqk,bkhd->bqhd', w.astype(v.dtype), v)

    out = lax.map(one_block, qb)
    return out.transpose(1, 0, 2, 3, 4).reshape(b, sq, h, ATT_VD)


def peer(h, wq, sub_keys, u_tab, v_tab):
    b, s, d = h.shape
    blocks = h.reshape(-1, TOKEN_BLOCK, d)

    def one_block(xb):
        q = (xb @ wq).reshape(TOKEN_BLOCK, PEER_HEADS, 2, PEER_HALF)
        s1 = jnp.einsum('thd,kd->thk', q[:, :, 0], sub_keys[0]).astype(jnp.float32)
        s2 = jnp.einsum('thd,kd->thk', q[:, :, 1], sub_keys[1]).astype(jnp.float32)
        v1, i1 = lax.top_k(s1, PEER_TOPK)
        v2, i2 = lax.top_k(s2, PEER_TOPK)
        n_cand = PEER_TOPK * PEER_TOPK
        cand_s = (v1[..., :, None] + v2[..., None, :]).reshape(TOKEN_BLOCK, PEER_HEADS, n_cand)
        cand_i = (i1[..., :, None] * N_KEYS + i2[..., None, :]).reshape(TOKEN_BLOCK, PEER_HEADS, n_cand)
        top_s, pos = lax.top_k(cand_s, PEER_TOPK)
        idx = jnp.take_along_axis(cand_i, pos, axis=-1)
        gate = jax.nn.softmax(top_s, axis=-1)
        u_e = jnp.take(u_tab, idx, axis=0)
        act = jax.nn.gelu(jnp.einsum('thkd,td->thk', u_e, xb).astype(jnp.float32))
        v_e = jnp.take(v_tab, idx, axis=0)
        return jnp.einsum('thk,thkd->td', (gate * act).astype(v_tab.dtype), v_e)

    out = lax.map(one_block, blocks)
    return out.reshape(b, s, d).astype(h.dtype)


def trunk_layer(x, cond, p, lam_init, rope, lru_h0, ctx_kv):
    b, s, _ = x.shape
    mod = (jax.nn.silu(cond) @ p['w_mod'] + p['b_mod'])[:, None, :]
    sh1, sc1, g1, sh2, sc2, g2 = jnp.split(mod, N_MOD, axis=-1)
    h = rmsnorm(x, p['norm1']) * (1.0 + sc1) + sh1
    a_u, a_v, r_x, r_g, q, k, v, br = jnp.split(h @ p['w_in'], IN_SPLITS, axis=-1)
    y_a = chunk_mlp(a_u, a_v, p['a_norm'], p['a_ws'], p['a_bs'])
    xc = centred_conv(r_x, p['lru_conv_w'], p['lru_conv_b'])
    if lru_h0 is None:
        zero = jnp.zeros((b, LRU_WIDTH), jnp.float32)
        lru_h0 = (zero, zero)
    hs_f, h_f = lru_direction(xc, p, 0, lru_h0[0])
    hs_b, h_b = lru_direction(jnp.flip(xc, axis=1), p, 1, lru_h0[1])
    y_b = (hs_f + jnp.flip(hs_b, axis=1)).astype(x.dtype) * jax.nn.gelu(r_g)
    q = q.reshape(b, s, ATT_HEADS, 2, ATT_HD)
    k = k.reshape(b, s, ATT_HEADS, 2, ATT_HD)
    v = v.reshape(b, s, ATT_HEADS, ATT_VD)
    ctx_state = (k.reshape(b, s, ATT_HEADS, ATT_VD), v, jnp.stack([h_f, h_b], axis=1))
    if rope is not None:
        q = apply_axial_rope(q, rope)
        k = apply_axial_rope(k, rope)
    if ctx_kv is not None:
        k_ctx, v_ctx = ctx_kv
        k = jnp.concatenate([k, k_ctx.reshape(b, -1, ATT_HEADS, 2, ATT_HD).astype(k.dtype)], axis=1)
        v = jnp.concatenate([v, v_ctx.astype(v.dtype)], axis=1)
    lp = p['att_lam']
    lam = jnp.exp(jnp.sum(lp[0] * lp[1])) - jnp.exp(jnp.sum(lp[2] * lp[3])) + lam_init
    o = diff_attention(q, k, v, lam)
    y_c = (rmsnorm(o, p['att_subln']) * (1.0 - lam_init)).reshape(b, s, ATT_WIDTH)
    g_a, g_b, g_c = jnp.split(jax.nn.sigmoid(br), N_BRANCH, axis=-1)
    merged = g_a * (y_a @ p['w_up_a']) + g_b * (y_b @ p['w_up_b']) + g_c * (y_c @ p['w_up_c'])
    x = x + g1 * (merged @ p['w_out'])
    h2 = rmsnorm(x, p['norm2']) * (1.0 + sc2) + sh2
    x = x + g2 * peer(h2, p['peer_wq'], p['peer_keys'], p['peer_u'], p['peer_v'])
    return x, ctx_state


def setup_inputs(seed: int = 0) -> dict:
    key = jax.random.key(seed)
    keys = jax.random.split(key, 40)
    f32 = jnp.float32

    def nrm(i, shape, scale):
        return jax.random.normal(keys[i], shape, f32) * scale

    a0 = jax.random.uniform(keys[13], (DEPTH, 2, LRU_WIDTH), f32, 0.9, 0.999)
    return {
        'x_prompt': nrm(0, (BATCH, SEQ, D_MODEL), 1.0),
        'x_sample': nrm(1, (DEC_BATCH, DEC_SEQ, D_MODEL), 1.0),
        'cache_k': nrm(2, (DEC_BATCH, DEPTH, PAST_LEN, ATT_HEADS, ATT_VD), 1.0),
        'cache_v': nrm(3, (DEC_BATCH, DEPTH, PAST_LEN, ATT_HEADS, ATT_VD), 1.0),
        'state_lru': nrm(4, (DEC_BATCH, DEPTH, 2, LRU_WIDTH), 0.5),
        'c': nrm(5, (DEC_BATCH, D_MODEL), 1.0),
        'c_ctx': nrm(6, (D_MODEL,), 1.0),
        'w_mod': nrm(7, (DEPTH, D_MODEL, N_MOD * D_MODEL), 0.5 * D_MODEL ** -0.5),
        'b_mod': nrm(8, (DEPTH, N_MOD * D_MODEL), 0.02),
        'norm1': 1.0 + nrm(9, (DEPTH, D_MODEL), 0.02),
        'norm2': 1.0 + nrm(10, (DEPTH, D_MODEL), 0.02),
        'w_in': nrm(11, (DEPTH, D_MODEL, IN_WIDTH), D_MODEL ** -0.5),
        'a_norm': 1.0 + nrm(12, (DEPTH, A_WIDTH), 0.02),
        'a_ws': nrm(14, (DEPTH, A_GROUPS, CHUNK, CHUNK), CHUNK ** -0.5),
        'a_bs': 1.0 + nrm(15, (DEPTH, A_GROUPS, CHUNK), 0.02),
        'lru_conv_w': nrm(16, (DEPTH, CONV_W, LRU_WIDTH), CONV_W ** -0.5),
        'lru_conv_b': nrm(17, (DEPTH, LRU_WIDTH), 0.02),
        'lru_w_r': nrm(18, (DEPTH, 2, LRU_BLOCKS, LRU_BLOCK_W, LRU_BLOCK_W), LRU_BLOCK_W ** -0.5),
        'lru_b_r': nrm(19, (DEPTH, 2, LRU_WIDTH), 0.1),
        'lru_w_i': nrm(20, (DEPTH, 2, LRU_BLOCKS, LRU_BLOCK_W, LRU_BLOCK_W), LRU_BLOCK_W ** -0.5),
        'lru_b_i': nrm(21, (DEPTH, 2, LRU_WIDTH), 0.1),
        'lru_lam': jnp.log(a0) - jnp.log1p(-a0),
        'att_lam': nrm(22, (DEPTH, 4, ATT_HD), 0.1),
        'att_subln': 1.0 + nrm(23, (DEPTH, ATT_VD), 0.02),
        'w_up_a': nrm(24, (DEPTH, A_WIDTH, D_MODEL), A_WIDTH ** -0.5),
        'w_up_b': nrm(25, (DEPTH, LRU_WIDTH, D_MODEL), LRU_WIDTH ** -0.5),
        'w_up_c': nrm(26, (DEPTH, ATT_WIDTH, D_MODEL), ATT_WIDTH ** -0.5),
        'w_out': nrm(27, (DEPTH, D_MODEL, D_MODEL), D_MODEL ** -0.5),
        'peer_wq': nrm(28, (DEPTH, D_MODEL, PEER_HEADS * PEER_QDIM), D_MODEL ** -0.5),
        'peer_keys': nrm(29, (DEPTH, 2, N_KEYS, PEER_HALF), PEER_HALF ** -0.5),
        'peer_u': nrm(30, (DEPTH, N_EXPERTS, D_MODEL), D_MODEL ** -0.5),
        'peer_v': nrm(31, (DEPTH, N_EXPERTS, D_MODEL), 0.25),
        'final_norm': 1.0 + nrm(32, (D_MODEL,), 0.02),
    }


def reference(x_prompt, x_sample, cache_k, cache_v, state_lru, c, c_ctx, w_mod, b_mod, norm1, norm2, w_in,
              a_norm, a_ws, a_bs, lru_conv_w, lru_conv_b, lru_w_r, lru_b_r, lru_w_i, lru_b_i, lru_lam,
              att_lam, att_subln, w_up_a, w_up_b, w_up_c, w_out, peer_wq, peer_keys, peer_u, peer_v, final_norm):
    rows = x_sample.shape[1] // GRID_W
    rope = axial_rope_tables(rows)
    cond_ctx = jnp.broadcast_to(c_ctx, (x_prompt.shape[0], D_MODEL))
    xp, xs = x_prompt, x_sample
    ks, vs, hs = [], [], []
    for i in range(DEPTH):
        lam_init = 0.8 - 0.6 * math.exp(-0.3 * i)
        p = {'w_mod': w_mod[i], 'b_mod': b_mod[i], 'norm1': norm1[i], 'norm2': norm2[i], 'w_in': w_in[i],
             'a_norm': a_norm[i], 'a_ws': a_ws[i], 'a_bs': a_bs[i],
             'lru_conv_w': lru_conv_w[i], 'lru_conv_b': lru_conv_b[i], 'lru_w_r': lru_w_r[i], 'lru_b_r': lru_b_r[i],
             'lru_w_i': lru_w_i[i], 'lru_b_i': lru_b_i[i], 'lru_lam': lru_lam[i],
             'att_lam': att_lam[i], 'att_subln': att_subln[i],
             'w_up_a': w_up_a[i], 'w_up_b': w_up_b[i], 'w_up_c': w_up_c[i], 'w_out': w_out[i],
             'peer_wq': peer_wq[i], 'peer_keys': peer_keys[i], 'peer_u': peer_u[i], 'peer_v': peer_v[i]}
        xp, (k_i, v_i, h_i) = trunk_layer(xp, cond_ctx, p, lam_init, None, None, None)
        ks.append(k_i)
        vs.append(v_i)
        hs.append(h_i)
        xs, _ = trunk_layer(xs, c, p, lam_init, rope, (state_lru[:, i, 0], state_lru[:, i, 1]),
                            (cache_k[:, i], cache_v[:, i]))
    y_prompt = rmsnorm(xp, final_norm)
    y_sample = rmsnorm(xs, final_norm)
    return (y_prompt, y_sample, jnp.stack(ks, axis=1), jnp.stack(vs, axis=1), jnp.stack(hs, axis=1))
```

```cpp
#include <hip/hip_runtime.h>
#include <hip/hip_cooperative_groups.h>
#include <cstdio>
#include <cstdint>
#include <cstring>
namespace cg = cooperative_groups;

typedef unsigned short u16;
typedef __attribute__((ext_vector_type(8))) short bf16x8;
typedef __attribute__((ext_vector_type(16))) float f32x16;

constexpr int T_CTX = 4096, T_ALL = 12288, DM = 1024, INW = 6656;
constexpr int OUT_YS = 4194304, OUT_K = 12582912, OUT_V = 16777216, OUT_LRU = 20971520;
constexpr int SMEM_BYTES = 75776;
constexpr int NPHASE = 20;

struct Params {
  const float* in[33];
  float* out;
  u16 *WtIn, *WtUpA, *WtUpB, *WtUpC, *WtOut, *WtQ, *KeysB, *AwsB, *LruWt, *PU, *PV;
  float *mod, *rope, *lam, *x;
  u16 *h, *proj, *hs, *ya, *yc, *Qb, *Kb, *Vt;
  int* pidx;
  float* pgate;
  u16* yb;
  float* xmid;
  int reps[12];
  int* xcnt;
  u16* acum;
  float* segtot;
};
struct Blk { int xcd, rank, nblk; };


typedef float f32x2_ __attribute__((ext_vector_type(2)));
typedef __bf16 bf16x2_ __attribute__((ext_vector_type(2)));
__device__ __forceinline__ uint32_t pack2(float a, float b) {
  f32x2_ v = {a, b};
  bf16x2_ r = __builtin_convertvector(v, bf16x2_);
  return __builtin_bit_cast(uint32_t, r);
}
__device__ __forceinline__ u16 f2bf(float f) { return (u16)(pack2(f, 0.f) & 0xffffu); }
__device__ __forceinline__ float bf2f(u16 h) { return __uint_as_float(((uint32_t)h) << 16); }
__device__ __forceinline__ float lo2f(uint32_t w) { return __uint_as_float(w << 16); }
__device__ __forceinline__ float hi2f(uint32_t w) { return __uint_as_float(w & 0xffff0000u); }
__device__ __forceinline__ float sigmoidf_(float x) { return __builtin_amdgcn_rcpf(1.f + __expf(-x)); }
__device__ __forceinline__ float gelu_tanh(float x) {
  float u = 0.7978845608028654f * (x + 0.044715f * x * x * x);
  return x * sigmoidf_(2.f * u);
}
__device__ __forceinline__ float wave_sum(float v) {
#pragma unroll
  for (int o = 32; o >= 1; o >>= 1) v += __shfl_xor(v, o);
  return v;
}
__device__ __forceinline__ int get_tid() {
  int t;
  asm volatile("v_mov_b32 %0, %1" : "=v"(t) : "v"((int)threadIdx.x));
  return t;
}
__device__ __forceinline__ size_t blk_off(int t, int c) { return (size_t)(c >> 6) * ((size_t)T_ALL * 64) + (size_t)t * 64 + (c & 63); }
__device__ __forceinline__ const float* in_xrow(const float* xp, const float* xs, int t) {
  return t < T_CTX ? xp + (size_t)t * DM : xs + (size_t)(t - T_CTX) * DM;
}
__device__ __forceinline__ int cond_of(int t) { return t < T_CTX ? 0 : 1 + ((t - T_CTX) >> 11); }
__device__ __forceinline__ float lam_init_of(int l) { return l == 0 ? 0.2f : 0.35550906759f; }

constexpr int LDS_STRIDE = 72;
typedef uint32_t u32x4 __attribute__((ext_vector_type(4)));
__device__ __forceinline__ void gl16(u32x4& r, const u16* p) {
  asm volatile("global_load_dwordx4 %0, %1, off" : "=v"(r) : "v"(p));
}
#define GLDS16(gptr, lptr) \
  __builtin_amdgcn_global_load_lds((const unsigned*)(gptr), (__attribute__((address_space(3))) unsigned*)(lptr), 16, 0, 0)
template <int NJ>
__device__ __forceinline__ void gemm_core(const u16* __restrict__ A, size_t ksA, const u16* __restrict__ Bt, size_t ksB, int K,
                                          f32x16 (&acc)[2][NJ], u16* sA, u16*  ) {
  constexpr int A_BYTES = 16384, B_BYTES = 8192 * NJ, STG_BYTES = A_BYTES + B_BYTES;
  char* lds = (char*)sA;
  const int tid = get_tid(), lane = tid & 63, wave = tid >> 6;
  const int wm = wave >> 1, wn = wave & 1;
  const int r = lane & 31, hh = lane >> 5;
  const int srcoff = (tid >> 3) * 64 + (((tid & 7) ^ ((tid >> 4) & 7)) * 8);
  const u16* ga = A + srcoff;
  const u16* gb = Bt + srcoff;
  char* la = lds + tid * 16;
#define GEMM_ISSUE(STG)                                                                                        \
  {                                                                                                            \
    char* l_ = la + (STG) * STG_BYTES;                                                                         \
    GLDS16(ga, l_); GLDS16(ga + 2048, l_ + 4096); GLDS16(ga + 4096, l_ + 8192); GLDS16(ga + 6144, l_ + 12288); \
    GLDS16(gb, l_ + A_BYTES); GLDS16(gb + 2048, l_ + A_BYTES + 4096);                                          \
    if (NJ == 2) { GLDS16(gb + 4096, l_ + A_BYTES + 8192); GLDS16(gb + 6144, l_ + A_BYTES + 12288); }          \
    ga += ksA; gb += ksB;                                                                                      \
  }
  const int nk = K >> 6;
  const int rswz = (r >> 1) & 7;
  const char* ra = lds + (wm * 64 + r) * 128;
  const char* rb = lds + A_BYTES + (wn * 32 * NJ + r) * 128;
  constexpr int NS = (NJ == 1) ? 3 : 2;
  if (NS == 3) asm volatile("s_waitcnt vmcnt(0)" ::: "memory");
  __syncthreads();
  GEMM_ISSUE(0)
  if (NS == 3) GEMM_ISSUE(1)
  int cs = 0;
  for (int kb = 0; kb < nk; kb++) {
    int cur;
    if (NS == 3) {
      if (kb + 1 < nk) asm volatile("s_waitcnt vmcnt(6)" ::: "memory");
      else asm volatile("s_waitcnt vmcnt(0)" ::: "memory");
      __builtin_amdgcn_s_barrier();
      asm volatile("" ::: "memory");
      cur = cs * STG_BYTES;
      const int ns = cs >= 1 ? cs - 1 : 2;
      if (kb + 2 < nk) GEMM_ISSUE(ns)
      cs = cs == 2 ? 0 : cs + 1;
    } else {
      asm volatile("s_waitcnt vmcnt(0)" ::: "memory");
      __builtin_amdgcn_s_barrier();
      asm volatile("" ::: "memory");
      cur = (kb & 1) * STG_BYTES;
      if (kb + 1 < nk) {
        if (kb & 1) GEMM_ISSUE(0) else GEMM_ISSUE(1)
      }
    }
    __builtin_amdgcn_sched_barrier(0);
    __builtin_amdgcn_s_setprio(1);
#pragma unroll
    for (int ks = 0; ks < 4; ks++) {
      const int co = (((ks * 2 + hh) ^ rswz) << 4) + cur;
      bf16x8 a[2], b[NJ];
#pragma unroll
      for (int i = 0; i < 2; i++) a[i] = *(const bf16x8*)(ra + i * 4096 + co);
#pragma unroll
      for (int j = 0; j < NJ; j++) b[j] = *(const bf16x8*)(rb + j * 4096 + co);
#pragma unroll
      for (int i = 0; i < 2; i++)
#pragma unroll
        for (int j = 0; j < NJ; j++) acc[i][j] = __builtin_amdgcn_mfma_f32_32x32x16_bf16(a[i], b[j], acc[i][j], 0, 0, 0);
    }
    __builtin_amdgcn_s_setprio(0);
  }
#undef GEMM_ISSUE
}
#define ACC_ZERO(acc)                                   \
  _Pragma("unroll") for (int i_ = 0; i_ < 2; i_++)      \
  _Pragma("unroll") for (int j_ = 0; j_ < 2; j_++)      \
  _Pragma("unroll") for (int r_ = 0; r_ < 16; r_++) acc[i_][j_][r_] = 0.f;
#define ACC_ROW(wm, i, r, lane) ((wm) * 64 + (i) * 32 + ((r) & 3) + 8 * ((r) >> 2) + 4 * ((lane) >> 5))
#define ACC_COL(wn, j, lane) ((wn) * 64 + (j) * 32 + ((lane) & 31))

template <int NJ>
__device__ __forceinline__ void stage_tile_bf16(const f32x16 (&acc)[2][NJ], u16* sC, int wm, int wn, int lane) {
  constexpr int CS = 64 * NJ + 8;
#pragma unroll
  for (int i = 0; i < 2; i++)
#pragma unroll
    for (int j = 0; j < NJ; j++)
#pragma unroll
      for (int r = 0; r < 16; r++)
        sC[(wm * 64 + i * 32 + (r & 3) + 8 * (r >> 2) + 4 * (lane >> 5)) * CS + wn * 32 * NJ + j * 32 + (lane & 31)] = f2bf(acc[i][j][r]);
}
template <bool CONTIG = false>
__device__ __forceinline__ void norm_emit(const float (&xv)[16], int lane, const float* __restrict__ gain,
                                          const float* __restrict__ sc, const float* __restrict__ sh, u16* hdst, int t, float* fdst) {
  float ss = 0.f;
#pragma unroll
  for (int e = 0; e < 16; e++) ss += xv[e] * xv[e];
  ss = wave_sum(ss);
  const float rstd = rsqrtf(ss * (1.f / 1024.f) + 1e-6f);
#pragma unroll
  for (int i = 0; i < 2; i++) {
    const int c0 = CONTIG ? lane * 16 + i * 8 : i * 512 + lane * 8;
    float y[8];
#pragma unroll
    for (int j = 0; j < 8; j++) {
      float v = xv[i * 8 + j] * rstd * gain[c0 + j];
      if (sc) v = v * (1.f + sc[c0 + j]) + sh[c0 + j];
      y[j] = v;
    }
    if (hdst) {
      uint4 o;
      o.x = pack2(y[0], y[1]); o.y = pack2(y[2], y[3]); o.z = pack2(y[4], y[5]); o.w = pack2(y[6], y[7]);
      *(uint4*)(hdst + blk_off(t, c0)) = o;
    } else {
      *(float4*)(fdst + c0) = make_float4(y[0], y[1], y[2], y[3]);
      *(float4*)(fdst + c0 + 4) = make_float4(y[4], y[5], y[6], y[7]);
    }
  }
}
template <bool CONTIG = false>
__device__ __forceinline__ void load_row16(const float* __restrict__ xr, int lane, float (&xv)[16]) {
#pragma unroll
  for (int i = 0; i < 2; i++) {
    const int c0 = CONTIG ? lane * 16 + i * 8 : i * 512 + lane * 8;
    float4 a = *(const float4*)(xr + c0);
    float4 b = *(const float4*)(xr + c0 + 4);
    xv[i * 8 + 0] = a.x; xv[i * 8 + 1] = a.y; xv[i * 8 + 2] = a.z; xv[i * 8 + 3] = a.w;
    xv[i * 8 + 4] = b.x; xv[i * 8 + 5] = b.y; xv[i * 8 + 6] = b.z; xv[i * 8 + 7] = b.w;
  }
}

__device__ void tr_tile(const float* __restrict__ src, int R, int C, u16* __restrict__ dst, int tr, int tc, float* sT) {
  const int tid = get_tid();
  const int r0 = tr * 64, c0 = tc * 64;
  __syncthreads();
#pragma unroll
  for (int i = 0; i < 4; i++) {
    int r = (tid >> 4) + 16 * i, c4 = (tid & 15) * 4;
    float4 v = *(const float4*)(src + (size_t)(r0 + r) * C + c0 + c4);
    sT[r * 65 + c4 + 0] = v.x; sT[r * 65 + c4 + 1] = v.y; sT[r * 65 + c4 + 2] = v.z; sT[r * 65 + c4 + 3] = v.w;
  }
  __syncthreads();
  const int c = tid >> 2, rq = (tid & 3) * 16;
  uint32_t w[8];
#pragma unroll
  for (int j = 0; j < 8; j++) w[j] = pack2(sT[(rq + 2 * j) * 65 + c], sT[(rq + 2 * j + 1) * 65 + c]);
  u16* d = dst + (size_t)tr * C * 64 + (size_t)(c0 + c) * 64 + rq;
  *(uint4*)(d) = make_uint4(w[0], w[1], w[2], w[3]);
  *(uint4*)(d + 8) = make_uint4(w[4], w[5], w[6], w[7]);
}
__device__ __forceinline__ void cvt_item(const float* __restrict__ src, u16* __restrict__ dst, size_t item) {
  size_t o = item * 2048 + (size_t)get_tid() * 8;
  float4 a = *(const float4*)(src + o), b = *(const float4*)(src + o + 4);
  *(uint4*)(dst + o) = make_uint4(pack2(a.x, a.y), pack2(a.z, a.w), pack2(b.x, b.y), pack2(b.z, b.w));
}

typedef float f32x2 __attribute__((ext_vector_type(2)));
__device__ __forceinline__ void cvt8_item(const float* __restrict__ src, unsigned char* __restrict__ dst, size_t item, float scale) {
  const size_t o = item * 8192 + (size_t)get_tid() * 8;
  float4 a[4], b[4];
#pragma unroll
  for (int q = 0; q < 4; q++) { a[q] = *(const float4*)(src + o + q * 2048); b[q] = *(const float4*)(src + o + q * 2048 + 4); }
#pragma unroll
  for (int q = 0; q < 4; q++) {
    int w0 = __builtin_amdgcn_cvt_pk_fp8_f32(a[q].x * scale, a[q].y * scale, 0, false);
    w0 = __builtin_amdgcn_cvt_pk_fp8_f32(a[q].z * scale, a[q].w * scale, w0, true);
    int w1 = __builtin_amdgcn_cvt_pk_fp8_f32(b[q].x * scale, b[q].y * scale, 0, false);
    w1 = __builtin_amdgcn_cvt_pk_fp8_f32(b[q].z * scale, b[q].w * scale, w1, true);
    *(uint2*)(dst + o + q * 2048) = make_uint2((uint32_t)w0, (uint32_t)w1);
  }
}
__device__ __forceinline__ void cvt4_item(const float* __restrict__ src, unsigned char* __restrict__ dst, size_t item, float scale) {
  const size_t o = item * 8192 + (size_t)get_tid() * 8;
  float4 a[4], b[4];
#pragma unroll
  for (int q = 0; q < 4; q++) { a[q] = *(const float4*)(src + o + q * 2048); b[q] = *(const float4*)(src + o + q * 2048 + 4); }
#pragma unroll
  for (int q = 0; q < 4; q++) {
    unsigned w = 0;
    w = __builtin_amdgcn_cvt_scalef32_pk_fp4_f32(w, a[q].x * scale, a[q].y * scale, 1.0f, 0);
    w = __builtin_amdgcn_cvt_scalef32_pk_fp4_f32(w, a[q].z * scale, a[q].w * scale, 1.0f, 1);
    w = __builtin_amdgcn_cvt_scalef32_pk_fp4_f32(w, b[q].x * scale, b[q].y * scale, 1.0f, 2);
    w = __builtin_amdgcn_cvt_scalef32_pk_fp4_f32(w, b[q].z * scale, b[q].w * scale, 1.0f, 3);
    *(uint32_t*)(dst + ((o + q * 2048) >> 1)) = w;
  }
}
constexpr bool U_FP4 = true, V_FP4 = true;
constexpr float PU_SCALE = U_FP4 ? 48.f : 64.f, PV_SCALE = V_FP4 ? 6.f : 8.f;
constexpr int PU_ROWB = U_FP4 ? 512 : 1024, PV_ROWB = V_FP4 ? 512 : 1024;
__device__ void ph_prologue(const Params& p, char* smem) {
  const int tid = get_tid();
  float* sf = (float*)smem;
  constexpr int N_MODI = 192, N_MISC = 1, N_TR = 5696, N_KEYS = 32, N_AWS = 64, N_X = 0, N_PU = 4096, N_PV = 4096;
  constexpr int B_MISC = N_MODI, B_TR = B_MISC + N_MISC, B_KEYS = B_TR + N_TR, B_AWS = B_KEYS + N_KEYS, B_X = B_AWS + N_AWS,
                B_PU = B_X + N_X, B_PV = B_PU + N_PU, N_TOTAL = B_PV + N_PV;
  for (int it = blockIdx.x; it < N_TOTAL; it += gridDim.x) {
    if (it < N_MODI) {
      const int l = it / 96, n0 = (it % 96) * 64;
      __syncthreads();
      for (int e = tid; e < 5 * 1024; e += 256) {
        int c = e >> 10, k = e & 1023;
        float v = (c == 0) ? p.in[6][k] : p.in[5][(c - 1) * 1024 + k];
        sf[e] = v * sigmoidf_(v);
      }
      __syncthreads();
      const int col = tid & 63, kq = tid >> 6;
      const float* w = p.in[7] + (size_t)l * 1024 * 6144 + n0 + col;
      float a0 = 0, a1 = 0, a2 = 0, a3 = 0, a4 = 0;
#pragma unroll 16
      for (int k = kq * 256; k < kq * 256 + 256; k++) {
        float wv = w[(size_t)k * 6144];
        a0 += sf[k] * wv; a1 += sf[1024 + k] * wv; a2 += sf[2048 + k] * wv; a3 += sf[3072 + k] * wv; a4 += sf[4096 + k] * wv;
      }
      float* sr = sf + 5120;
      sr[(kq * 5 + 0) * 64 + col] = a0; sr[(kq * 5 + 1) * 64 + col] = a1; sr[(kq * 5 + 2) * 64 + col] = a2;
      sr[(kq * 5 + 3) * 64 + col] = a3; sr[(kq * 5 + 4) * 64 + col] = a4;
      __syncthreads();
      for (int e = tid; e < 320; e += 256) {
        int c = e >> 6, cc = e & 63;
        float s = sr[(0 * 5 + c) * 64 + cc] + sr[(1 * 5 + c) * 64 + cc] + sr[(2 * 5 + c) * 64 + cc] + sr[(3 * 5 + c) * 64 + cc];
        p.mod[((size_t)l * 5 + c) * 6144 + n0 + cc] = s + p.in[8][l * 6144 + n0 + cc];
      }
    } else if (it < B_TR) {
      for (int e = tid; e < 1536; e += 256) {
        int pos, f;
        if (e < 512) { pos = e >> 4; f = e & 15; } else { pos = (e - 512) >> 4; f = (e - 512) & 15; }
        float inv = powf(10000.f, -(float)f / 16.f);
        float ang = (float)pos * inv;
        p.rope[2 * e] = cosf(ang);
        p.rope[2 * e + 1] = sinf(ang);
      }
      if (tid < 128) {
        int l = tid >> 6, i = tid & 63;
        const float* lp = p.in[22] + l * 256;
        float s1 = wave_sum(lp[i] * lp[64 + i]);
        float s2 = wave_sum(lp[128 + i] * lp[192 + i]);
        if (i == 0) p.lam[l] = expf(s1) - expf(s2) + lam_init_of(l);
      }
    } else if (it < B_KEYS) {
      int j = it - B_TR;
      const int l = j / 2848; j -= l * 2848;
      if (j < 1664) tr_tile(p.in[11] + (size_t)l * 1024 * INW, 1024, INW, p.WtIn + (size_t)l * INW * 1024, j / 104, j % 104, sf);
      else if (j < 1792) { j -= 1664; tr_tile(p.in[24] + (size_t)l * 524288, 512, 1024, p.WtUpA + (size_t)l * 524288, j / 16, j % 16, sf); }
      else if (j < 1920) { j -= 1792; tr_tile(p.in[25] + (size_t)l * 524288, 512, 1024, p.WtUpB + (size_t)l * 524288, j / 16, j % 16, sf); }
      else if (j < 2048) { j -= 1920; tr_tile(p.in[26] + (size_t)l * 524288, 512, 1024, p.WtUpC + (size_t)l * 524288, j / 16, j % 16, sf); }
      else if (j < 2304) { j -= 2048; tr_tile(p.in[27] + (size_t)l * 1048576, 1024, 1024, p.WtOut + (size_t)l * 1048576, j / 16, j % 16, sf); }
      else if (j < 2816) { j -= 2304; tr_tile(p.in[28] + (size_t)l * 2097152, 1024, 2048, p.WtQ + (size_t)l * 2097152, j / 32, j % 32, sf); }
      else {
        j -= 2816;
        const int ri = j >> 4, dh = j & 15;
        tr_tile(p.in[ri ? 19 : 17] + (size_t)l * 65536 + dh * 4096, 64, 64, p.LruWt + (size_t)l * 131072 + (ri * 16 + dh) * 4096, 0, 0, sf);
      }
    } else if (it < B_AWS) {
      cvt_item(p.in[29], p.KeysB, it - B_KEYS);
    } else if (it < B_X) {
      cvt_item(p.in[13], p.AwsB, it - B_AWS);
    } else if (it < B_PV) {
      if (U_FP4) cvt4_item(p.in[30], (unsigned char*)p.PU, it - B_PU, PU_SCALE);
      else cvt8_item(p.in[30], (unsigned char*)p.PU, it - B_PU, PU_SCALE);
    } else {
      if (V_FP4) cvt4_item(p.in[31], (unsigned char*)p.PV, it - B_PV, PV_SCALE);
      else cvt8_item(p.in[31], (unsigned char*)p.PV, it - B_PV, PV_SCALE);
    }
  }
}

__device__ void ph_norm(const Params& p, int l, int which) {
  const int tid_ = get_tid(), lane = tid_ & 63, wave = tid_ >> 6;
  for (int t = blockIdx.x * 4 + wave; t < T_ALL; t += gridDim.x * 4) {
    float xv[16];
    load_row16(which == 0 ? in_xrow(p.in[0], p.in[1], t) : p.xmid + (size_t)t * DM, lane, xv);
    const float* m = p.mod + ((size_t)l * 5 + cond_of(t)) * 6144;
    if (which == 0) norm_emit(xv, lane, p.in[9] + l * DM, m + 1024, m, p.h, t, nullptr);
    else norm_emit(xv, lane, p.in[10] + l * DM, m + 4096, m + 3072, p.h, t, nullptr);
  }
}

__device__ void ph_gemm_in(const Params& p, int l, char* smem, const Blk& bk) {
  u16* sA = (u16*)smem; u16* sB = sA + 2 * 128 * LDS_STRIDE;
  const int tid_ = get_tid(), lane = tid_ & 63, wave = tid_ >> 6, wm = wave >> 1, wn = wave & 1;
  constexpr int NT = INW / 128;
  const int xcd = bk.xcd;
  for (int lt = bk.rank; lt < 12 * NT; lt += bk.nblk) {
    const int mt = xcd * 12 + lt % 12, nt = lt / 12;
    f32x16 acc[2][2];
    ACC_ZERO(acc);
    gemm_core<2>(p.h + (size_t)mt * 128 * 64, (size_t)T_ALL * 64, p.WtIn + (size_t)l * INW * DM + (size_t)nt * 128 * 64, (size_t)INW * 64, DM, acc, sA, sB);
    __syncthreads();
    stage_tile_bf16<2>(acc, sA, wm, wn, lane);
    __syncthreads();
    {
      const int tid = wave * 64 + lane;
#pragma unroll
      for (int q = 0; q < 8; q++) {
        const int idx = tid + 256 * q, row = idx >> 4, ch = idx & 15;
        *(uint4*)(p.proj + (size_t)(mt * 128 + row) * INW + nt * 128 + ch * 8) = *(const uint4*)(sA + row * 136 + ch * 8);
      }
    }
    if (mt * 128 < T_CTX && nt * 128 >= 2560 && nt * 128 < 3584) {
      float* ob = p.out + (nt * 128 < 3072 ? OUT_K - 2560 : OUT_V - 3072);
#pragma unroll
      for (int i = 0; i < 2; i++)
#pragma unroll
        for (int j = 0; j < 2; j++) {
          const int n = nt * 128 + ACC_COL(wn, j, lane);
#pragma unroll
          for (int r = 0; r < 16; r++) {
            const int t = mt * 128 + ACC_ROW(wm, i, r, lane);
            const int b = t >> 8, sq = t & 255;
            ob[((size_t)(b * 2 + l) * 256 + sq) * 512 + n] = acc[i][j][r];
          }
        }
    }
  }
}

__device__ void item_chunk_mlp(const Params& p, int l, int chunk, int g, char* smem) {
  const int tid = get_tid(), lane = tid & 63, wave = tid >> 6, wm = wave >> 1, wn = wave & 1;
  u16* sVt = (u16*)smem;
  float* sR = (float*)(smem + 128 * 136 * 2);
  const int t0 = chunk * 128;
  __syncthreads();
  {
    const int q = tid >> 1, hf = tid & 1;
    const u16* vp = p.proj + (size_t)(t0 + q) * INW + 512 + hf * 256;
    float ss = 0.f;
#pragma unroll 4
    for (int i = 0; i < 32; i++) {
      uint4 w = *(const uint4*)(vp + i * 8);
      float a;
      a = lo2f(w.x); ss += a * a; a = hi2f(w.x); ss += a * a;
      a = lo2f(w.y); ss += a * a; a = hi2f(w.y); ss += a * a;
      a = lo2f(w.z); ss += a * a; a = hi2f(w.z); ss += a * a;
      a = lo2f(w.w); ss += a * a; a = hi2f(w.w); ss += a * a;
    }
    ss += __shfl_xor(ss, 1);
    if (hf == 0) sR[q] = rsqrtf(ss * (1.f / 512.f) + 1e-6f);
  }
  __syncthreads();
  {
    const int q = tid >> 1, cb = (tid & 1) * 64;
    const float rs = sR[q];
    const u16* vp = p.proj + (size_t)(t0 + q) * INW + 512 + g * 128 + cb;
    const float* gv = p.in[12] + l * 512 + g * 128 + cb;
#pragma unroll
    for (int i = 0; i < 8; i++) {
      uint4 w = *(const uint4*)(vp + i * 8);
      uint32_t ww[4] = {w.x, w.y, w.z, w.w};
#pragma unroll
      for (int j = 0; j < 4; j++) {
        int c = cb + i * 8 + 2 * j;
        sVt[c * 136 + q] = f2bf(lo2f(ww[j]) * rs * gv[i * 8 + 2 * j]);
        sVt[(c + 1) * 136 + q] = f2bf(hi2f(ww[j]) * rs * gv[i * 8 + 2 * j + 1]);
      }
    }
  }
  __syncthreads();
  const u16* Aw = p.AwsB + (size_t)l * 65536 + g * 16384;
  f32x16 acc[2][2];
  ACC_ZERO(acc);
#pragma unroll
  for (int ks = 0; ks < 8; ks++) {
    bf16x8 a[2], b[2];
#pragma unroll
    for (int i = 0; i < 2; i++) {
      a[i] = *(const bf16x8*)(Aw + (wm * 64 + i * 32 + (lane & 31)) * 128 + ks * 16 + (lane >> 5) * 8);
      b[i] = *(const bf16x8*)(sVt + (wn * 64 + i * 32 + (lane & 31)) * 136 + ks * 16 + (lane >> 5) * 8);
    }
#pragma unroll
    for (int i = 0; i < 2; i++)
#pragma unroll
      for (int j = 0; j < 2; j++) acc[i][j] = __builtin_amdgcn_mfma_f32_32x32x16_bf16(a[i], b[j], acc[i][j], 0, 0, 0);
  }
  __syncthreads();
  float* sM = (float*)smem;
#pragma unroll
  for (int i = 0; i < 2; i++)
#pragma unroll
    for (int j = 0; j < 2; j++)
#pragma unroll
      for (int r = 0; r < 16; r++) sM[ACC_ROW(wm, i, r, lane) * 132 + ACC_COL(wn, j, lane)] = acc[i][j][r];
  __syncthreads();
  {
    const int pp = tid >> 1, cb = (tid & 1) * 64;
    const float bsv = p.in[14][l * 512 + g * 128 + pp];
    const u16* up = p.proj + (size_t)(t0 + pp) * INW + g * 128 + cb;
    u16* yp = p.ya + blk_off(t0 + pp, g * 128 + cb);
    const float* mp = sM + pp * 132 + cb;
#pragma unroll 2
    for (int i = 0; i < 8; i++) {
      const uint4 w = *(const uint4*)(up + i * 8);
      const float4 m0 = *(const float4*)(mp + i * 8), m1 = *(const float4*)(mp + i * 8 + 4);
      uint4 o;
      o.x = pack2(lo2f(w.x) * (m0.x + bsv), hi2f(w.x) * (m0.y + bsv));
      o.y = pack2(lo2f(w.y) * (m0.z + bsv), hi2f(w.y) * (m0.w + bsv));
      o.z = pack2(lo2f(w.z) * (m1.x + bsv), hi2f(w.z) * (m1.y + bsv));
      o.w = pack2(lo2f(w.w) * (m1.z + bsv), hi2f(w.w) * (m1.w + bsv));
      *(uint4*)(yp + i * 8) = o;
    }
  }
}

__device__ void item_lru(const Params& p, int l, int seq, int seg, int d, int hb, char* smem) {
  const int tid = get_tid(), lane = tid & 63, wave = tid >> 6;
  float* sXf = (float*)smem;
  float* sA_ = sXf + 64 * 65;
  float* sBx = sA_ + 64 * 65;
  float* sPar = sBx + 64 * 65;
  u16* sXb = (u16*)(sPar + 512);
  const bool lat = seq >= 16;
  const int L = lat ? 2048 : 256;
  const int tok0 = lat ? T_CTX + (seq - 16) * 2048 : seq * 256;
  __syncthreads();
  if (tid < 64) {
    const int ch = hb * 64 + tid;
#pragma unroll
    for (int j = 0; j < 4; j++) sPar[j * 64 + tid] = p.in[15][l * 2048 + j * 512 + ch];
    sPar[256 + tid] = p.in[16][l * 512 + ch];
    const float lm = p.in[21][(l * 2 + d) * 512 + ch];
    sPar[320 + tid] = (-lm > 20.f) ? -lm : log1pf(expf(-lm));
    sPar[384 + tid] = p.in[18][(l * 2 + d) * 512 + ch];
    sPar[448 + tid] = p.in[20][(l * 2 + d) * 512 + ch];
  }
  const int th = wave & 1, nt = wave >> 1;
  bf16x8 wr[4], wi[4];
  {
    const u16* Wr = p.LruWt + (size_t)l * 131072 + ((0 * 2 + d) * 8 + hb) * 4096;
    const u16* Wi = p.LruWt + (size_t)l * 131072 + ((1 * 2 + d) * 8 + hb) * 4096;
#pragma unroll
    for (int ks = 0; ks < 4; ks++) {
      wr[ks] = *(const bf16x8*)(Wr + (nt * 32 + (lane & 31)) * 64 + ks * 16 + (lane >> 5) * 8);
      wi[ks] = *(const bf16x8*)(Wi + (nt * 32 + (lane & 31)) * 64 + ks * 16 + (lane >> 5) * 8);
    }
  }
  float hstate = 0.f, acum = 1.f;
  u16* acg = p.acum + (size_t)d * T_ALL * 512;
  u16* hs = p.hs + (size_t)d * T_ALL * 512;
  __syncthreads();
  const int r = tid >> 2, cq = (tid & 3) * 16;
  for (int ti = 0; ti < 4; ti++) {
    const int pos = seg * 256 + ti * 64 + r;
    const int ts = d == 0 ? pos : L - 1 - pos;
    {
      float xc[16];
#pragma unroll
      for (int c = 0; c < 16; c++) xc[c] = sPar[256 + cq + c];
#pragma unroll
      for (int j = 0; j < 4; j++) {
        const int tt = ts + j - 2;
        if (tt >= 0 && tt < L) {
          const u16* xp = p.proj + (size_t)(tok0 + tt) * INW + 1024 + hb * 64 + cq;
          uint4 w0 = *(const uint4*)xp, w1 = *(const uint4*)(xp + 8);
          uint32_t ww[8] = {w0.x, w0.y, w0.z, w0.w, w1.x, w1.y, w1.z, w1.w};
#pragma unroll
          for (int c = 0; c < 8; c++) {
            xc[2 * c] += lo2f(ww[c]) * sPar[j * 64 + cq + 2 * c];
            xc[2 * c + 1] += hi2f(ww[c]) * sPar[j * 64 + cq + 2 * c + 1];
          }
        }
      }
#pragma unroll
      for (int c = 0; c < 16; c++) sXf[r * 65 + cq + c] = xc[c];
      uint4 o0 = make_uint4(pack2(xc[0], xc[1]), pack2(xc[2], xc[3]), pack2(xc[4], xc[5]), pack2(xc[6], xc[7]));
      uint4 o1 = make_uint4(pack2(xc[8], xc[9]), pack2(xc[10], xc[11]), pack2(xc[12], xc[13]), pack2(xc[14], xc[15]));
      *(uint4*)(sXb + r * 72 + cq) = o0;
      *(uint4*)(sXb + r * 72 + cq + 8) = o1;
    }
    __syncthreads();
    {
      f32x16 ar, ai;
#pragma unroll
      for (int q = 0; q < 16; q++) { ar[q] = 0.f; ai[q] = 0.f; }
#pragma unroll
      for (int ks = 0; ks < 4; ks++) {
        bf16x8 a = *(const bf16x8*)(sXb + (th * 32 + (lane & 31)) * 72 + ks * 16 + (lane >> 5) * 8);
        ar = __builtin_amdgcn_mfma_f32_32x32x16_bf16(a, wr[ks], ar, 0, 0, 0);
        ai = __builtin_amdgcn_mfma_f32_32x32x16_bf16(a, wi[ks], ai, 0, 0, 0);
      }
      const int ch = nt * 32 + (lane & 31);
      const float sp = sPar[320 + ch], br_ = sPar[384 + ch], bi_ = sPar[448 + ch];
#pragma unroll
      for (int q = 0; q < 16; q++) {
        const int tk = th * 32 + (q & 3) + 8 * (q >> 2) + 4 * (lane >> 5);
        const float rr = sigmoidf_(ar[q] + br_), ii = sigmoidf_(ai[q] + bi_);
        const float la = -8.f * rr * sp;
        const float a = __expf(la);
        const float om = fmaxf(1.f - __expf(2.f * la), 0.f);
        sA_[tk * 65 + ch] = a;
        sBx[tk * 65 + ch] = __builtin_amdgcn_sqrtf(om) * ii * sXf[tk * 65 + ch];
      }
    }
    __syncthreads();
    if (tid < 64) {
#pragma unroll 8
      for (int q = 0; q < 64; q++) {
        const float a = sA_[q * 65 + tid];
        hstate = a * hstate + sBx[q * 65 + tid];
        acum *= a;
        sBx[q * 65 + tid] = hstate;
        sA_[q * 65 + tid] = acum;
      }
    }
    __syncthreads();
    {
      float v[16];
#pragma unroll
      for (int c = 0; c < 16; c++) v[c] = sBx[r * 65 + cq + c];
      u16* dp = hs + (size_t)(tok0 + ts) * 512 + hb * 64 + cq;
      *(uint4*)dp = make_uint4(pack2(v[0], v[1]), pack2(v[2], v[3]), pack2(v[4], v[5]), pack2(v[6], v[7]));
      *(uint4*)(dp + 8) = make_uint4(pack2(v[8], v[9]), pack2(v[10], v[11]), pack2(v[12], v[13]), pack2(v[14], v[15]));
      if (lat) {
#pragma unroll
        for (int c = 0; c < 16; c++) v[c] = sA_[r * 65 + cq + c];
        u16* ap = acg + (size_t)(tok0 + ts) * 512 + hb * 64 + cq;
        *(uint4*)ap = make_uint4(pack2(v[0], v[1]), pack2(v[2], v[3]), pack2(v[4], v[5]), pack2(v[6], v[7]));
        *(uint4*)(ap + 8) = make_uint4(pack2(v[8], v[9]), pack2(v[10], v[11]), pack2(v[12], v[13]), pack2(v[14], v[15]));
      }
    }
    __syncthreads();
  }
  if (tid < 64) {
    if (!lat) p.out[OUT_LRU + ((seq * 2 + l) * 2 + d) * 512 + hb * 64 + tid] = hstate;
    else {
      float* st = p.segtot + ((((size_t)(seq - 16) * 2 + d) * 8 + seg) * 2) * 512 + hb * 64 + tid;
      st[0] = acum;
      st[512] = hstate;
    }
  }
}

__device__ __forceinline__ size_t kv_base(int seq) { return seq < 16 ? (size_t)seq * 131072 : (size_t)2097152 + (size_t)(seq - 16) * 1310720; }
__device__ __forceinline__ int kperm(int pp) { return 8 * ((pp & 7) >> 2) + 4 * (pp >> 3) + (pp & 3); }

template <bool CACHE>
__device__ void item_prep(const Params& p, int l, int seq, int tile, char* smem) {
  const int tid = get_tid();
  u16* sV = (u16*)smem;
  const bool lat = seq >= 16;
  const int NK = lat ? 2560 : 256;
  const int L = lat ? 2048 : 256;
  const int tok0 = lat ? T_CTX + (seq - 16) * 2048 : seq * 256;
  const int s0 = tile * 64;
  const int key0 = CACHE ? 2048 + s0 : s0;
  const size_t base = kv_base(seq);
  (void)L;
  if (!CACHE) {
    for (int u = tid; u < 2048; u += 256) {
      const int rr = u >> 5, vid = (u >> 1) & 15, ax = u & 1;
      const int isk = vid >> 3, head = (vid >> 1) & 3, half = vid & 1;
      const int s = s0 + rr;
      const u16* src = p.proj + (size_t)(tok0 + s) * INW + (isk ? 2560 : 2048) + head * 128 + half * 64 + ax * 32;
      uint4 w[4];
#pragma unroll
      for (int i = 0; i < 4; i++) w[i] = *(const uint4*)(src + i * 8);
      uint32_t ww[16] = {w[0].x, w[0].y, w[0].z, w[0].w, w[1].x, w[1].y, w[1].z, w[1].w,
                         w[2].x, w[2].y, w[2].z, w[2].w, w[3].x, w[3].y, w[3].z, w[3].w};
      float x1[16], x2[16];
#pragma unroll
      for (int i = 0; i < 8; i++) {
        x1[2 * i] = lo2f(ww[i]); x1[2 * i + 1] = hi2f(ww[i]);
        x2[2 * i] = lo2f(ww[8 + i]); x2[2 * i + 1] = hi2f(ww[8 + i]);
      }
      const float scl = isk ? 1.f : 0.125f * 1.4426950408889634f;
      float o1[16], o2[16];
      if (lat) {
        const float* tab = ax == 0 ? p.rope + 2 * ((s >> 6) * 16) : p.rope + 2 * (512 + (s & 63) * 16);
#pragma unroll
        for (int i = 0; i < 16; i++) {
          const float cs = tab[2 * i], sn = tab[2 * i + 1];
          o1[i] = (x1[i] * cs - x2[i] * sn) * scl;
          o2[i] = (x1[i] * sn + x2[i] * cs) * scl;
        }
      } else {
#pragma unroll
        for (int i = 0; i < 16; i++) { o1[i] = x1[i] * scl; o2[i] = x2[i] * scl; }
      }
      u16* dst = isk ? p.Kb + base + ((size_t)(head * 2 + half) * NK + s) * 64 + ax * 32
                     : p.Qb + (size_t)(tok0 + s) * 512 + head * 128 + half * 64 + ax * 32;
      *(uint4*)(dst) = make_uint4(pack2(o1[0], o1[1]), pack2(o1[2], o1[3]), pack2(o1[4], o1[5]), pack2(o1[6], o1[7]));
      *(uint4*)(dst + 8) = make_uint4(pack2(o1[8], o1[9]), pack2(o1[10], o1[11]), pack2(o1[12], o1[13]), pack2(o1[14], o1[15]));
      *(uint4*)(dst + 16) = make_uint4(pack2(o2[0], o2[1]), pack2(o2[2], o2[3]), pack2(o2[4], o2[5]), pack2(o2[6], o2[7]));
      *(uint4*)(dst + 24) = make_uint4(pack2(o2[8], o2[9]), pack2(o2[10], o2[11]), pack2(o2[12], o2[13]), pack2(o2[14], o2[15]));
    }
  } else {
    const float* ck = p.in[2] + ((size_t)((seq - 16) * 2 + l) * 512 + s0) * 512;
    for (int u = tid; u < 4096; u += 256) {
      const int rr = u >> 6, head = (u >> 4) & 3, half = (u >> 3) & 1, c8 = u & 7;
      const float* src = ck + (size_t)rr * 512 + head * 128 + half * 64 + c8 * 8;
      float4 a = *(const float4*)src, b = *(const float4*)(src + 4);
      u16* dst = p.Kb + base + ((size_t)(head * 2 + half) * NK + key0 + rr) * 64 + c8 * 8;
      *(uint4*)dst = make_uint4(pack2(a.x, a.y), pack2(a.z, a.w), pack2(b.x, b.y), pack2(b.z, b.w));
    }
  }
  for (int head = 0; head < 4; head++) {
    __syncthreads();
    for (int u = tid; u < 1024; u += 256) {
      const int rr = u >> 4, c8 = u & 15;
      uint4 o;
      if (CACHE) {
        const float* src = p.in[3] + ((size_t)((seq - 16) * 2 + l) * 512 + s0 + rr) * 512 + head * 128 + c8 * 8;
        float4 a = *(const float4*)src, b = *(const float4*)(src + 4);
        o = make_uint4(pack2(a.x, a.y), pack2(a.z, a.w), pack2(b.x, b.y), pack2(b.z, b.w));
      } else {
        o = *(const uint4*)(p.proj + (size_t)(tok0 + s0 + rr) * INW + 3072 + head * 128 + c8 * 8);
      }
      *(uint4*)(sV + rr * 136 + c8 * 8) = o;
    }
    __syncthreads();
    {
      const int dv = tid >> 1, kb0 = (tid & 1) * 2;
#pragma unroll
      for (int kk = 0; kk < 2; kk++) {
        const int kb = kb0 + kk;
        uint32_t w[8];
#pragma unroll
        for (int pp = 0; pp < 8; pp++) {
          const u16 a = sV[(kb * 16 + kperm(2 * pp)) * 136 + dv];
          const u16 b = sV[(kb * 16 + kperm(2 * pp + 1)) * 136 + dv];
          w[pp] = (uint32_t)a | ((uint32_t)b << 16);
        }
        u16* dst = p.Vt + base + (size_t)head * 128 * NK + (size_t)((key0 + kb * 16) >> 5) * 4096 + dv * 32 + (kb & 1) * 16;
        *(uint4*)dst = make_uint4(w[0], w[1], w[2], w[3]);
        *(uint4*)(dst + 8) = make_uint4(w[4], w[5], w[6], w[7]);
      }
    }
  }
}

__device__ void ph_mixers(const Params& p, int l, char* smem) {
  for (int it = blockIdx.x; it < 224; it += gridDim.x) {
    if (it < 192) {
      int j = it;
      if (j < 64) item_prep<false>(p, l, j >> 2, j & 3, smem);
      else { j -= 64; item_prep<false>(p, l, 16 + (j >> 5), j & 31, smem); }
    } else { int j = it - 192; item_prep<true>(p, l, 16 + (j >> 3), j & 7, smem); }
  }
}

__device__ void item_attn(const Params& p, int l, int seq, int head, int qb, char* smem) {
  const int tid_ = get_tid(), lane = tid_ & 63, wave = tid_ >> 6;
  const int qs = wave >> 1, hf = wave & 1;
  float* sO = (float*)smem;
  const bool lat = seq >= 16;
  const int NK = lat ? 2560 : 256;
  const int tok0 = lat ? T_CTX + (seq - 16) * 2048 : seq * 256;
  const size_t base = kv_base(seq);
  const int q0 = qb * 64 + qs * 32;
  const int ql = lane & 31, hh = lane >> 5;
  bf16x8 qf[4];
#pragma unroll
  for (int ks = 0; ks < 4; ks++)
    qf[ks] = *(const bf16x8*)(p.Qb + (size_t)(tok0 + q0 + ql) * 512 + head * 128 + hf * 64 + ks * 16 + hh * 8);
  f32x16 O[4];
#pragma unroll
  for (int mt = 0; mt < 4; mt++)
#pragma unroll
    for (int r = 0; r < 16; r++) O[mt][r] = 0.f;
  float m_ = 0.f, l_ = 0.f;
  f32x16 negm;
#pragma unroll
  for (int r = 0; r < 16; r++) negm[r] = 0.f;
  constexpr int KST = 64 * 72, VST = 128 * 40, STG = KST + VST;
  u16* sKV = (u16*)smem;
  const int tid = wave * 64 + lane;
  const u16* Kg0 = p.Kb + base + (size_t)(head * 2) * NK * 64 + tid * 8;
  const u16* Kg1 = Kg0 + (size_t)NK * 64;
  const u16* Vg = p.Vt + base + (size_t)head * 128 * NK + tid * 8;
  u16* wk0 = sKV + ((tid >> 3) & 31) * 72 + (tid & 7) * 8;
  u16* wk1 = wk0 + 32 * 72;
  u16* wv0 = sKV + KST + (tid >> 2) * 40 + (tid & 3) * 8;
  u16* wv1 = wv0 + 64 * 40;
  const u16* rk = sKV + (hf * 32 + ql) * 72 + hh * 8;
  const u16* rv = sKV + KST + ql * 40 + hh * 8;
#define BC(x) __builtin_bit_cast(bf16x8, x)
#define LD4(p) (*(const u32x4*)(p))
  const int nkt = NK / 32;
  u32x4 gk0 = LD4(Kg0), gk1 = LD4(Kg1), gv0 = LD4(Vg), gv1 = LD4(Vg + 2048);
  __syncthreads();
  *(u32x4*)wk0 = gk0; *(u32x4*)wk1 = gk1; *(u32x4*)wv0 = gv0; *(u32x4*)wv1 = gv1;
  {
    const int k1 = nkt > 1 ? 1 : 0;
    gk0 = LD4(Kg0 + (size_t)k1 * 2048); gk1 = LD4(Kg1 + (size_t)k1 * 2048);
    gv0 = LD4(Vg + (size_t)k1 * 4096); gv1 = LD4(Vg + (size_t)k1 * 4096 + 2048);
  }
  for (int kt = 0; kt < nkt; kt++) {
    __syncthreads();
    const int cur = (kt & 1) * STG, nxt = STG - cur;
    if (kt + 1 < nkt) {
      *(u32x4*)(wk0 + nxt) = gk0; *(u32x4*)(wk1 + nxt) = gk1; *(u32x4*)(wv0 + nxt) = gv0; *(u32x4*)(wv1 + nxt) = gv1;
    }
    {
      const int k2 = (kt + 2 < nkt) ? kt + 2 : nkt - 1;
      gk0 = LD4(Kg0 + (size_t)k2 * 2048); gk1 = LD4(Kg1 + (size_t)k2 * 2048);
      gv0 = LD4(Vg + (size_t)k2 * 4096); gv1 = LD4(Vg + (size_t)k2 * 4096 + 2048);
    }
    __builtin_amdgcn_sched_barrier(0);
    const bf16x8 kc0 = *(const bf16x8*)(rk + cur), kc1 = *(const bf16x8*)(rk + cur + 16), kc2 = *(const bf16x8*)(rk + cur + 32),
                 kc3 = *(const bf16x8*)(rk + cur + 48);
    const bf16x8 v0 = *(const bf16x8*)(rv + cur), v1 = *(const bf16x8*)(rv + cur + 16);
    const bf16x8 v2 = *(const bf16x8*)(rv + cur + 32 * 40), v3 = *(const bf16x8*)(rv + cur + 32 * 40 + 16);
    const bf16x8 v4 = *(const bf16x8*)(rv + cur + 64 * 40), v5 = *(const bf16x8*)(rv + cur + 64 * 40 + 16);
    const bf16x8 v6 = *(const bf16x8*)(rv + cur + 96 * 40), v7 = *(const bf16x8*)(rv + cur + 96 * 40 + 16);
    f32x16 s = __builtin_amdgcn_mfma_f32_32x32x16_bf16(kc0, qf[0], negm, 0, 0, 0);
    s = __builtin_amdgcn_mfma_f32_32x32x16_bf16(kc1, qf[1], s, 0, 0, 0);
    s = __builtin_amdgcn_mfma_f32_32x32x16_bf16(kc2, qf[2], s, 0, 0, 0);
    s = __builtin_amdgcn_mfma_f32_32x32x16_bf16(kc3, qf[3], s, 0, 0, 0);
    float mx = fmaxf(s[0], s[1]);
#pragma unroll
    for (int r = 2; r < 16; r += 2) mx = fmaxf(mx, fmaxf(s[r], s[r + 1]));
    mx = fmaxf(mx, __shfl_xor(mx, 32));
    if (kt == 0 || __builtin_amdgcn_ballot_w64(mx > 8.f) != 0ull) {
      const float d = kt == 0 ? mx : fmaxf(mx, 0.f);
      const float alpha = kt == 0 ? 1.f : __builtin_amdgcn_exp2f(-d);
      l_ *= alpha;
      m_ += d;
#pragma unroll
      for (int r = 0; r < 16; r++) { s[r] -= d; negm[r] = -m_; }
#pragma unroll
      for (int mt = 0; mt < 4; mt++)
#pragma unroll
        for (int r = 0; r < 16; r++) O[mt][r] *= alpha;
    }
    float rs = 0.f;
#pragma unroll
    for (int r = 0; r < 16; r++) { s[r] = __builtin_amdgcn_exp2f(s[r]); rs += s[r]; }
    rs += __shfl_xor(rs, 32);
    l_ += rs;
    bf16x8 pf0, pf1;
    {
      typedef uint32_t u32x4_ __attribute__((ext_vector_type(4)));
      u32x4_ w0, w1;
      w0[0] = pack2(s[0], s[1]); w0[1] = pack2(s[2], s[3]); w0[2] = pack2(s[4], s[5]); w0[3] = pack2(s[6], s[7]);
      w1[0] = pack2(s[8], s[9]); w1[1] = pack2(s[10], s[11]); w1[2] = pack2(s[12], s[13]); w1[3] = pack2(s[14], s[15]);
      pf0 = __builtin_bit_cast(bf16x8, w0);
      pf1 = __builtin_bit_cast(bf16x8, w1);
    }
    O[0] = __builtin_amdgcn_mfma_f32_32x32x16_bf16(v0, pf0, O[0], 0, 0, 0);
    O[0] = __builtin_amdgcn_mfma_f32_32x32x16_bf16(v1, pf1, O[0], 0, 0, 0);
    O[1] = __builtin_amdgcn_mfma_f32_32x32x16_bf16(v2, pf0, O[1], 0, 0, 0);
    O[1] = __builtin_amdgcn_mfma_f32_32x32x16_bf16(v3, pf1, O[1], 0, 0, 0);
    O[2] = __builtin_amdgcn_mfma_f32_32x32x16_bf16(v4, pf0, O[2], 0, 0, 0);
    O[2] = __builtin_amdgcn_mfma_f32_32x32x16_bf16(v5, pf1, O[2], 0, 0, 0);
    O[3] = __builtin_amdgcn_mfma_f32_32x32x16_bf16(v6, pf0, O[3], 0, 0, 0);
    O[3] = __builtin_amdgcn_mfma_f32_32x32x16_bf16(v7, pf1, O[3], 0, 0, 0);
    __builtin_amdgcn_sched_barrier(0);
  }
  const float lam = p.lam[l];
  const float sc = hf == 0 ? 1.f / l_ : lam / l_;
  __syncthreads();
  if (hf == 1) {
#pragma unroll
    for (int mt = 0; mt < 4; mt++)
#pragma unroll
      for (int r = 0; r < 16; r++) sO[(qs * 64 + mt * 16 + r) * 64 + lane] = O[mt][r] * sc;
  }
  __syncthreads();
  if (hf == 0) {
    float ss = 0.f;
#pragma unroll
    for (int mt = 0; mt < 4; mt++)
#pragma unroll
      for (int r = 0; r < 16; r++) {
        const float o = O[mt][r] * sc - sO[(qs * 64 + mt * 16 + r) * 64 + lane];
        O[mt][r] = o;
        ss += o * o;
      }
    ss += __shfl_xor(ss, 32);
    const float rstd = rsqrtf(ss * (1.f / 128.f) + 1e-6f) * (1.f - lam_init_of(l));
    const float* sub = p.in[23] + l * 128;
    const int tq = tok0 + q0 + ql;
#pragma unroll
    for (int mt = 0; mt < 4; mt++)
#pragma unroll
      for (int g = 0; g < 4; g++) {
        const int dv = mt * 32 + 8 * g + 4 * hh;
        const float4 sb = *(const float4*)(sub + dv);
        uint2 o;
        o.x = pack2(O[mt][4 * g] * rstd * sb.x, O[mt][4 * g + 1] * rstd * sb.y);
        o.y = pack2(O[mt][4 * g + 2] * rstd * sb.z, O[mt][4 * g + 3] * rstd * sb.w);
        *(uint2*)(p.yc + blk_off(tq, head * 128 + dv)) = o;
      }
  }
}

__device__ void ph_attn(const Params& p, int l, char* smem) {
  for (int it = blockIdx.x; it < 1920; it += gridDim.x) {
    if (it < 512) item_attn(p, l, 16 + (it >> 7), (it >> 5) & 3, it & 31, smem);
    else if (it < 1024) { int j = it - 512; item_lru(p, l, 16 + (j >> 7), (j >> 4) & 7, (j >> 3) & 1, j & 7, smem); }
    else if (it < 1280) { int j = it - 1024; item_lru(p, l, j >> 4, 0, (j >> 3) & 1, j & 7, smem); }
    else if (it < 1536) { int j = it - 1280; item_attn(p, l, j >> 4, (j >> 2) & 3, j & 3, smem); }
    else { int j = it - 1536; item_chunk_mlp(p, l, j >> 2, j & 3, smem); }
  }
}
__device__ void ph_combine(const Params& p, int l) {
  for (int it = blockIdx.x + 768; it < 768 + 384; it += gridDim.x) {
    {
      const int tid = get_tid();
      const int c = (tid & 63) * 8, tl = tid >> 6;
      const int t0 = (it - 768) * 32;
      float hinf[8], hinb[8];
#pragma unroll
      for (int j = 0; j < 8; j++) { hinf[j] = 0.f; hinb[j] = 0.f; }
      const bool latc = t0 >= T_CTX;
      if (latc) {
        const int sq = (t0 - T_CTX) >> 11, spos = (t0 - T_CTX) & 2047;
#pragma unroll
        for (int d = 0; d < 2; d++) {
          const int sg = (d == 0 ? spos : 2047 - spos) >> 8;
          float hin[8];
          const float* h0 = p.in[4] + ((sq * 2 + l) * 2 + d) * 512 + c;
#pragma unroll
          for (int j = 0; j < 8; j++) hin[j] = h0[j];
          const float* st = p.segtot + (((size_t)sq * 2 + d) * 8) * 2 * 512 + c;
          for (int j2 = 0; j2 < sg; j2++) {
            const float4 a0 = *(const float4*)(st + j2 * 1024), a1 = *(const float4*)(st + j2 * 1024 + 4);
            const float4 b0 = *(const float4*)(st + j2 * 1024 + 512), b1 = *(const float4*)(st + j2 * 1024 + 516);
            hin[0] = a0.x * hin[0] + b0.x; hin[1] = a0.y * hin[1] + b0.y; hin[2] = a0.z * hin[2] + b0.z; hin[3] = a0.w * hin[3] + b0.w;
            hin[4] = a1.x * hin[4] + b1.x; hin[5] = a1.y * hin[5] + b1.y; hin[6] = a1.z * hin[6] + b1.z; hin[7] = a1.w * hin[7] + b1.w;
          }
#pragma unroll
          for (int j = 0; j < 8; j++) { if (d == 0) hinf[j] = hin[j]; else hinb[j] = hin[j]; }
        }
      }
#pragma unroll 2
      for (int i = 0; i < 8; i++) {
        const int t = t0 + tl + 4 * i;
        const size_t o = (size_t)t * 512 + c;
        const uint4 f = *(const uint4*)(p.hs + o), b = *(const uint4*)(p.hs + (size_t)T_ALL * 512 + o);
        const uint4 g = *(const uint4*)(p.proj + (size_t)t * INW + 1536 + c);
        float hv[8];
        hv[0] = lo2f(f.x) + lo2f(b.x); hv[1] = hi2f(f.x) + hi2f(b.x); hv[2] = lo2f(f.y) + lo2f(b.y); hv[3] = hi2f(f.y) + hi2f(b.y);
        hv[4] = lo2f(f.z) + lo2f(b.z); hv[5] = hi2f(f.z) + hi2f(b.z); hv[6] = lo2f(f.w) + lo2f(b.w); hv[7] = hi2f(f.w) + hi2f(b.w);
        if (latc) {
          const uint4 af = *(const uint4*)(p.acum + o), ab = *(const uint4*)(p.acum + (size_t)T_ALL * 512 + o);
          hv[0] += lo2f(af.x) * hinf[0] + lo2f(ab.x) * hinb[0]; hv[1] += hi2f(af.x) * hinf[1] + hi2f(ab.x) * hinb[1];
          hv[2] += lo2f(af.y) * hinf[2] + lo2f(ab.y) * hinb[2]; hv[3] += hi2f(af.y) * hinf[3] + hi2f(ab.y) * hinb[3];
          hv[4] += lo2f(af.z) * hinf[4] + lo2f(ab.z) * hinb[4]; hv[5] += hi2f(af.z) * hinf[5] + hi2f(ab.z) * hinb[5];
          hv[6] += lo2f(af.w) * hinf[6] + lo2f(ab.w) * hinb[6]; hv[7] += hi2f(af.w) * hinf[7] + hi2f(ab.w) * hinb[7];
        }
        uint4 oo;
        oo.x = pack2(hv[0] * gelu_tanh(lo2f(g.x)), hv[1] * gelu_tanh(hi2f(g.x)));
        oo.y = pack2(hv[2] * gelu_tanh(lo2f(g.y)), hv[3] * gelu_tanh(hi2f(g.y)));
        oo.z = pack2(hv[4] * gelu_tanh(lo2f(g.z)), hv[5] * gelu_tanh(hi2f(g.z)));
        oo.w = pack2(hv[6] * gelu_tanh(lo2f(g.w)), hv[7] * gelu_tanh(hi2f(g.w)));
        *(uint4*)(p.yb + blk_off(t, c)) = oo;
      }
    }
  }
}

__device__ void ph_merge(const Params& p, int l, char* smem, const Blk& bk) {
  u16* sA = (u16*)smem; u16* sB = sA + 2 * 128 * LDS_STRIDE;
  const int tid_ = get_tid(), lane = tid_ & 63, wave = tid_ >> 6, wm = wave >> 1, wn = wave & 1;
  const int xcd = bk.xcd;
  for (int lt = bk.rank; lt < 12 * 16; lt += bk.nblk) {
    const int mt = xcd * 12 + lt % 12, nt = lt / 12;
    const int n = nt * 64 + wn * 32 + (lane & 31);
    f32x16 mg[2][1];
#pragma unroll
    for (int i = 0; i < 2; i++)
#pragma unroll
      for (int r = 0; r < 16; r++) mg[i][0][r] = 0.f;
#pragma unroll 1
    for (int br = 0; br < 3; br++) {
      const u16* A = (br == 0 ? p.ya : br == 1 ? p.yb : p.yc) + (size_t)mt * 128 * 64;
      const u16* W = (br == 0 ? p.WtUpA : br == 1 ? p.WtUpB : p.WtUpC) + (size_t)l * 524288 + (size_t)nt * 64 * 64;
      f32x16 acc[2][1];
#pragma unroll
      for (int i = 0; i < 2; i++)
#pragma unroll
        for (int r = 0; r < 16; r++) acc[i][0][r] = 0.f;
      gemm_core<1>(A, (size_t)T_ALL * 64, W, (size_t)1024 * 64, 512, acc, sA, sB);
      __syncthreads();
      {
        const int tid = get_tid();
#pragma unroll
        for (int q = 0; q < 4; q++) {
          const int row = (tid >> 3) + 32 * q, c8 = (tid & 7) * 8;
          *(uint4*)(sA + row * LDS_STRIDE + c8) =
              *(const uint4*)(p.proj + (size_t)(mt * 128 + row) * INW + 3584 + br * 1024 + nt * 64 + c8);
        }
      }
      __syncthreads();
#pragma unroll
      for (int i = 0; i < 2; i++)
#pragma unroll
        for (int r = 0; r < 16; r++) {
          const int row = ACC_ROW(wm, i, r, lane);
          const float g = sigmoidf_(bf2f(sA[row * LDS_STRIDE + wn * 32 + (lane & 31)]));
          mg[i][0][r] += g * acc[i][0][r];
        }
    }
    __syncthreads();
    stage_tile_bf16<1>(mg, sA, wm, wn, lane);
    __syncthreads();
    {
      const int tid = wave * 64 + lane;
      u16* dst = p.h + blk_off(mt * 128, nt * 64);
#pragma unroll
      for (int q = 0; q < 4; q++) {
        const int idx = tid + 256 * q, row = idx >> 3, ch = idx & 7;
        *(uint4*)(dst + row * 64 + ch * 8) = *(const uint4*)(sA + row * 72 + ch * 8);
      }
    }
  }
}

__device__ void ph_out(const Params& p, int l, char* smem, const Blk& bk) {
  u16* sA = (u16*)smem; u16* sB = sA + 2 * 128 * LDS_STRIDE;
  const int tid_ = get_tid(), lane = tid_ & 63, wave = tid_ >> 6, wm = wave >> 1, wn = wave & 1;
  const int xcd = bk.xcd;
  for (int lt = bk.rank; lt < 12 * 16; lt += bk.nblk) {
    const int mt = xcd * 12 + lt % 12, nt = lt / 12;
    f32x16 acc[2][1];
#pragma unroll
    for (int i = 0; i < 2; i++)
#pragma unroll
      for (int r = 0; r < 16; r++) acc[i][0][r] = 0.f;
    gemm_core<1>(p.h + (size_t)mt * 128 * 64, (size_t)T_ALL * 64, p.WtOut + (size_t)l * 1048576 + (size_t)nt * 64 * 64, (size_t)1024 * 64, DM, acc, sA, sB);
    __syncthreads();
    float* sF = (float*)smem;
#pragma unroll
    for (int i = 0; i < 2; i++)
#pragma unroll
      for (int r = 0; r < 16; r++) sF[ACC_ROW(wm, i, r, lane) * 68 + wn * 32 + (lane & 31)] = acc[i][0][r];
    __syncthreads();
    {
      const int tid = wave * 64 + lane;
      const float* gm = p.mod + ((size_t)l * 5 + cond_of(mt * 128)) * 6144 + 2048 + nt * 64;
#pragma unroll
      for (int q = 0; q < 8; q++) {
        const int idx = tid + 256 * q, row = idx >> 4, c4 = (idx & 15) * 4;
        const int t = mt * 128 + row;
        const float* xr = (l == 0 ? in_xrow(p.in[0], p.in[1], t) : p.x + (size_t)t * DM) + nt * 64 + c4;
        const float4 xv = *(const float4*)xr, g = *(const float4*)(gm + c4), a = *(const float4*)(sF + row * 68 + c4);
        *(float4*)(p.xmid + (size_t)t * DM + nt * 64 + c4) = make_float4(xv.x + g.x * a.x, xv.y + g.y * a.y, xv.z + g.z * a.z, xv.w + g.w * a.w);
      }
    }
  }
}

__device__ void ph_peer_q(const Params& p, int l, char* smem, const Blk& bk) {
  u16* sA = (u16*)smem; u16* sB = sA + 2 * 128 * LDS_STRIDE;
  const int tid_ = get_tid(), lane = tid_ & 63, wave = tid_ >> 6, wm = wave >> 1, wn = wave & 1;
  u16* pq = p.proj;
  const int xcd = bk.xcd;
  for (int lt = bk.rank; lt < 12 * 16; lt += bk.nblk) {
    const int mt = xcd * 12 + lt % 12, nt = lt / 12;
    f32x16 acc[2][2];
    ACC_ZERO(acc);
    gemm_core<2>(p.h + (size_t)mt * 128 * 64, (size_t)T_ALL * 64, p.WtQ + (size_t)l * 2097152 + (size_t)nt * 128 * 64, (size_t)2048 * 64, DM, acc, sA, sB);
    __syncthreads();
    stage_tile_bf16<2>(acc, sA, wm, wn, lane);
    __syncthreads();
    {
      const int tid = wave * 64 + lane;
#pragma unroll
      for (int q = 0; q < 8; q++) {
        const int idx = tid + 256 * q, row = idx >> 4, ch = idx & 15;
        *(uint4*)(pq + (size_t)(mt * 128 + row) * 2048 + nt * 128 + ch * 8) = *(const uint4*)(sA + row * 136 + ch * 8);
      }
    }
  }
}

__device__ __forceinline__ void ins16(float (&lst)[16], float v) {
#pragma unroll
  for (int j = 0; j < 16; j++) {
    const float hi = fmaxf(lst[j], v);
    v = fminf(lst[j], v);
    lst[j] = hi;
  }
}
template <int CTRL>
__device__ __forceinline__ float dppf(float v) {
  return __uint_as_float((uint32_t)__builtin_amdgcn_update_dpp(0, (int)__float_as_uint(v), CTRL, 0xf, 0xf, true));
}
template <int CTRL>
__device__ __forceinline__ void merge16(float (&lst)[16]) {
  float o[16];
#pragma unroll
  for (int j = 0; j < 16; j++) o[j] = dppf<CTRL>(lst[j]);
#pragma unroll
  for (int j = 0; j < 16; j++) lst[j] = fmaxf(lst[j], o[15 - j]);
#define BSTAGE(ST)                                                                    \
  _Pragma("unroll") for (int i = 0; i < 16; i++)                                       \
    if ((i & ST) == 0) {                                                               \
      const float hi = fmaxf(lst[i], lst[i + ST]), lo = fminf(lst[i], lst[i + ST]);    \
      lst[i] = hi; lst[i + ST] = lo;                                                   \
    }
  BSTAGE(8) BSTAGE(4) BSTAGE(2) BSTAGE(1)
#undef BSTAGE
}
__device__ void ph_route(const Params& p, int l, char* smem) {
  const int tid = get_tid(), lane = tid & 63, wave = tid >> 6;
  float* sS = (float*)smem;
  uint32_t* sTop = (uint32_t*)(sS + 2 * 64 * 129);
  const u16* pq = p.proj;
  for (int it = blockIdx.x; it < 192 * 8; it += gridDim.x) {
    const int tt = it >> 3, head = it & 7;
    const int t0 = tt * 64;
    __syncthreads();
    {
      const int half = wave & 1, kh = wave >> 1;
      const u16* A = pq + (size_t)t0 * 2048 + head * 256 + half * 128;
      const u16* B = p.KeysB + (size_t)l * 32768 + half * 16384 + (size_t)kh * 64 * 128;
      f32x16 acc[2][2];
      ACC_ZERO(acc);
#pragma unroll
      for (int ks = 0; ks < 8; ks++) {
        bf16x8 a[2], b[2];
#pragma unroll
        for (int i = 0; i < 2; i++) {
          a[i] = *(const bf16x8*)(A + (size_t)(i * 32 + (lane & 31)) * 2048 + ks * 16 + (lane >> 5) * 8);
          b[i] = *(const bf16x8*)(B + (i * 32 + (lane & 31)) * 128 + ks * 16 + (lane >> 5) * 8);
        }
#pragma unroll
        for (int i = 0; i < 2; i++)
#pragma unroll
          for (int j = 0; j < 2; j++) acc[i][j] = __builtin_amdgcn_mfma_f32_32x32x16_bf16(a[i], b[j], acc[i][j], 0, 0, 0);
      }
#pragma unroll
      for (int i = 0; i < 2; i++)
#pragma unroll
        for (int j = 0; j < 2; j++) {
          const int key = kh * 64 + j * 32 + (lane & 31);
#pragma unroll
          for (int r = 0; r < 16; r++) {
            const int tk = i * 32 + (r & 3) + 8 * (r >> 2) + 4 * (lane >> 5);
            sS[(half * 64 + tk) * 129 + key] = acc[i][j][r];
          }
        }
    }
    __syncthreads();
    {
      const int tokl = lane >> 2, sub = lane & 3, half = sub >> 1, part = sub & 1;
      const int tok = wave * 16 + tokl;
      const float* row = sS + (half * 64 + tok) * 129 + part * 64;
      float lst[16];
#pragma unroll
      for (int j = 0; j < 16; j++) lst[j] = -3.0e38f;
#pragma unroll 4
      for (int k = 0; k < 64; k++) {
        const float v = __uint_as_float((__float_as_uint(row[k]) & 0xffffff80u) | (uint32_t)(part * 64 + k));
        ins16(lst, v);
      }
      merge16<0xB1>(lst);
      float a[16], b[16];
#pragma unroll
      for (int j = 0; j < 16; j++) {
        const float o = dppf<0x4E>(lst[j]);
        a[j] = half ? o : lst[j];
        b[j] = half ? lst[j] : o;
      }
      float cl[16];
#pragma unroll
      for (int j = 0; j < 16; j++) cl[j] = -3.0e38f;
      {
        float val = -3.0e38f;
        int c = 0;
#pragma unroll
        for (int i = 0; i < 16; i++)
#pragma unroll
          for (int j = 0; j < 16; j++)
            if ((i + 1) * (j + 1) <= 16) {
              const float sm = __uint_as_float(__float_as_uint(a[i]) & 0xffffff80u) + __uint_as_float(__float_as_uint(b[j]) & 0xffffff80u);
              const float pv = __uint_as_float((__float_as_uint(sm) & 0xffffff00u) | (uint32_t)(i * 16 + j));
              val = ((c & 3) == sub) ? pv : val;
              if ((c & 3) == 3) { ins16(cl, val); val = -3.0e38f; }
              c++;
            }
        ins16(cl, val);
      }
      merge16<0xB1>(cl);
      merge16<0x4E>(cl);
      float mx = -3.0e38f;
#pragma unroll
      for (int j = 0; j < 16; j++) mx = fmaxf(mx, __uint_as_float(__float_as_uint(cl[j]) & 0xffffff00u));
      float sum = 0.f;
#pragma unroll
      for (int j = 0; j < 16; j++) sum += __expf(__uint_as_float(__float_as_uint(cl[j]) & 0xffffff00u) - mx);
      const float inv = __builtin_amdgcn_rcpf(sum);
      int* ip = p.pidx + (size_t)(t0 + tok) * 128 + head * 16 + sub * 4;
      float* gp = p.pgate + (size_t)(t0 + tok) * 128 + head * 16 + sub * 4;
      const uint32_t sm0 = sub == 0 ? 0xffffffffu : 0u, sm1 = sub == 1 ? 0xffffffffu : 0u, sm2 = sub == 2 ? 0xffffffffu : 0u,
                     sm3 = sub == 3 ? 0xffffffffu : 0u;
#pragma unroll
      for (int jj = 0; jj < 4; jj++) {
        const float ent = __uint_as_float((__float_as_uint(cl[jj]) & sm0) | (__float_as_uint(cl[4 + jj]) & sm1) |
                                          (__float_as_uint(cl[8 + jj]) & sm2) | (__float_as_uint(cl[12 + jj]) & sm3));
        const uint32_t code = __float_as_uint(ent) & 0xffu;
        const int ci = code >> 4, cj = code & 15;
        uint32_t ai = 0, bj = 0;
#pragma unroll
        for (int q = 0; q < 16; q++) { ai = (ci == q) ? __float_as_uint(a[q]) : ai; bj = (cj == q) ? __float_as_uint(b[q]) : bj; }
        ip[jj] = (int)((ai & 127u) * 128u + (bj & 127u));
        gp[jj] = __expf(__uint_as_float(__float_as_uint(ent) & 0xffffff00u) - mx) * inv;
      }
    }
  }
}

__device__ __forceinline__ float dot16_fp8(const uint4& w, const float (&hx)[16]) {
  float s = 0.f;
  f32x2 a;
  a = __builtin_amdgcn_cvt_pk_f32_fp8((int)w.x, false); s += a.x * hx[0] + a.y * hx[1];
  a = __builtin_amdgcn_cvt_pk_f32_fp8((int)w.x, true);  s += a.x * hx[2] + a.y * hx[3];
  a = __builtin_amdgcn_cvt_pk_f32_fp8((int)w.y, false); s += a.x * hx[4] + a.y * hx[5];
  a = __builtin_amdgcn_cvt_pk_f32_fp8((int)w.y, true);  s += a.x * hx[6] + a.y * hx[7];
  a = __builtin_amdgcn_cvt_pk_f32_fp8((int)w.z, false); s += a.x * hx[8] + a.y * hx[9];
  a = __builtin_amdgcn_cvt_pk_f32_fp8((int)w.z, true);  s += a.x * hx[10] + a.y * hx[11];
  a = __builtin_amdgcn_cvt_pk_f32_fp8((int)w.w, false); s += a.x * hx[12] + a.y * hx[13];
  a = __builtin_amdgcn_cvt_pk_f32_fp8((int)w.w, true);  s += a.x * hx[14] + a.y * hx[15];
  return s;
}
__device__ __forceinline__ float dot16_fp4(const uint2& w, const f32x2 (&hx2)[8]) {
  f32x2 s = __builtin_amdgcn_cvt_scalef32_pk_f32_fp4(w.x, 1.0f, 0) * hx2[0];
  s += __builtin_amdgcn_cvt_scalef32_pk_f32_fp4(w.x, 1.0f, 1) * hx2[1];
  s += __builtin_amdgcn_cvt_scalef32_pk_f32_fp4(w.x, 1.0f, 2) * hx2[2];
  s += __builtin_amdgcn_cvt_scalef32_pk_f32_fp4(w.x, 1.0f, 3) * hx2[3];
  s += __builtin_amdgcn_cvt_scalef32_pk_f32_fp4(w.y, 1.0f, 0) * hx2[4];
  s += __builtin_amdgcn_cvt_scalef32_pk_f32_fp4(w.y, 1.0f, 1) * hx2[5];
  s += __builtin_amdgcn_cvt_scalef32_pk_f32_fp4(w.y, 1.0f, 2) * hx2[6];
  s += __builtin_amdgcn_cvt_scalef32_pk_f32_fp4(w.y, 1.0f, 3) * hx2[7];
  return s.x + s.y;
}
__device__ __forceinline__ void axpy16_fp4(const uint2& w, float c, f32x2 (&acc2)[8]) {
  const f32x2 c2 = {c, c};
  acc2[0] += c2 * __builtin_amdgcn_cvt_scalef32_pk_f32_fp4(w.x, 1.0f, 0);
  acc2[1] += c2 * __builtin_amdgcn_cvt_scalef32_pk_f32_fp4(w.x, 1.0f, 1);
  acc2[2] += c2 * __builtin_amdgcn_cvt_scalef32_pk_f32_fp4(w.x, 1.0f, 2);
  acc2[3] += c2 * __builtin_amdgcn_cvt_scalef32_pk_f32_fp4(w.x, 1.0f, 3);
  acc2[4] += c2 * __builtin_amdgcn_cvt_scalef32_pk_f32_fp4(w.y, 1.0f, 0);
  acc2[5] += c2 * __builtin_amdgcn_cvt_scalef32_pk_f32_fp4(w.y, 1.0f, 1);
  acc2[6] += c2 * __builtin_amdgcn_cvt_scalef32_pk_f32_fp4(w.y, 1.0f, 2);
  acc2[7] += c2 * __builtin_amdgcn_cvt_scalef32_pk_f32_fp4(w.y, 1.0f, 3);
}
__device__ __forceinline__ void axpy16_fp8(const uint4& w, float c, float (&acc)[16]) {
  f32x2 a;
  a = __builtin_amdgcn_cvt_pk_f32_fp8((int)w.x, false); acc[0] += c * a.x; acc[1] += c * a.y;
  a = __builtin_amdgcn_cvt_pk_f32_fp8((int)w.x, true);  acc[2] += c * a.x; acc[3] += c * a.y;
  a = __builtin_amdgcn_cvt_pk_f32_fp8((int)w.y, false); acc[4] += c * a.x; acc[5] += c * a.y;
  a = __builtin_amdgcn_cvt_pk_f32_fp8((int)w.y, true);  acc[6] += c * a.x; acc[7] += c * a.y;
  a = __builtin_amdgcn_cvt_pk_f32_fp8((int)w.z, false); acc[8] += c * a.x; acc[9] += c * a.y;
  a = __builtin_amdgcn_cvt_pk_f32_fp8((int)w.z, true);  acc[10] += c * a.x; acc[11] += c * a.y;
  a = __builtin_amdgcn_cvt_pk_f32_fp8((int)w.w, false); acc[12] += c * a.x; acc[13] += c * a.y;
  a = __builtin_amdgcn_cvt_pk_f32_fp8((int)w.w, true);  acc[14] += c * a.x; acc[15] += c * a.y;
}
__device__ __forceinline__ float reduce16(const float (&part)[16], int b5, int b4, int b3, int b2) {
  float p8[8], p4[4], p2[2], p1;
#pragma unroll
  for (int i = 0; i < 8; i++) {
    const float keep = b5 ? part[8 + i] : part[i], send = b5 ? part[i] : part[8 + i];
    p8[i] = keep + __shfl_xor(send, 32);
  }
#pragma unroll
  for (int i = 0; i < 4; i++) {
    const float keep = b4 ? p8[4 + i] : p8[i], send = b4 ? p8[i] : p8[4 + i];
    p4[i] = keep + __shfl_xor(send, 16);
  }
#pragma unroll
  for (int i = 0; i < 2; i++) {
    const float keep = b3 ? p4[2 + i] : p4[i], send = b3 ? p4[i] : p4[2 + i];
    p2[i] = keep + __shfl_xor(send, 8);
  }
  {
    const float keep = b2 ? p2[1] : p2[0], send = b2 ? p2[0] : p2[1];
    p1 = keep + __shfl_xor(send, 4);
  }
  p1 += __shfl_xor(p1, 2);
  p1 += __shfl_xor(p1, 1);
  return p1;
}
__device__ void ph_gather(const Params& p, int l, char* smem) {
  const int tid_ = get_tid(), lane = tid_ & 63, wave = tid_ >> 6;
  const unsigned char* PU = (const unsigned char*)p.PU + (size_t)l * 16384 * PU_ROWB;
  const unsigned char* PV = (const unsigned char*)p.PV + (size_t)l * 16384 * PV_ROWB;
  const int b5 = (lane >> 5) & 1, b4 = (lane >> 4) & 1, b3 = (lane >> 3) & 1, b2 = (lane >> 2) & 1;
  for (int t = blockIdx.x * 4 + wave; t < T_ALL; t += gridDim.x * 4) {
    float hx[16];
    {
      const u16* hr = p.h + blk_off(t, lane * 16);
      uint4 w0 = *(const uint4*)(hr), w1 = *(const uint4*)(hr + 8);
      hx[0] = lo2f(w0.x); hx[1] = hi2f(w0.x); hx[2] = lo2f(w0.y); hx[3] = hi2f(w0.y);
      hx[4] = lo2f(w0.z); hx[5] = hi2f(w0.z); hx[6] = lo2f(w0.w); hx[7] = hi2f(w0.w);
      hx[8] = lo2f(w1.x); hx[9] = hi2f(w1.x); hx[10] = lo2f(w1.y); hx[11] = hi2f(w1.y);
      hx[12] = lo2f(w1.z); hx[13] = hi2f(w1.z); hx[14] = lo2f(w1.w); hx[15] = hi2f(w1.w);
    }
    float acc[16];
#pragma unroll
    for (int j = 0; j < 16; j++) acc[j] = 0.f;
    f32x2 hx2[8], acc2[8];
#pragma unroll
    for (int j = 0; j < 8; j++) { hx2[j][0] = hx[2 * j]; hx2[j][1] = hx[2 * j + 1]; acc2[j][0] = 0.f; acc2[j][1] = 0.f; }
    const int me = (lane >> 2) & 15;
    float* sW = (float*)smem + wave * 512;
    if (U_FP4) {
#pragma unroll 1
      for (int head = 0; head < 8; head += 2) {
        const int myidx = p.pidx[(size_t)t * 128 + head * 16 + (lane & 31)];
        float pa[16], pb[16];
        {
          uint2 w[32];
#pragma unroll
          for (int e = 0; e < 32; e++) {
            const int idx = __builtin_amdgcn_readlane(myidx, e);
            w[e] = *(const uint2*)(PU + (size_t)idx * 512 + lane * 8);
          }
          __builtin_amdgcn_sched_barrier(0);
#pragma unroll
          for (int e = 0; e < 16; e++) { pa[e] = dot16_fp4(w[e], hx2); pb[e] = dot16_fp4(w[16 + e], hx2); }
          __builtin_amdgcn_sched_barrier(0);
        }
        const float ra = reduce16(pa, b5, b4, b3, b2), rb = reduce16(pb, b5, b4, b3, b2);
        sW[head * 64 + lane] = p.pgate[(size_t)t * 128 + head * 16 + me] * gelu_tanh(ra * (1.f / PU_SCALE)) * (1.f / PV_SCALE);
        sW[(head + 1) * 64 + lane] = p.pgate[(size_t)t * 128 + (head + 1) * 16 + me] * gelu_tanh(rb * (1.f / PU_SCALE)) * (1.f / PV_SCALE);
        __builtin_amdgcn_sched_barrier(0);
      }
    } else {
#pragma unroll 1
      for (int head = 0; head < 8; head++) {
        const int myidx = p.pidx[(size_t)t * 128 + head * 16 + (lane & 15)];
        float part[16];
#pragma unroll
        for (int eg = 0; eg < 2; eg++) {
          uint4 w[8];
#pragma unroll
          for (int e = 0; e < 8; e++) {
            const int idx = __builtin_amdgcn_readlane(myidx, eg * 8 + e);
            w[e] = *(const uint4*)(PU + (size_t)idx * 1024 + lane * 16);
          }
#pragma unroll
          for (int e = 0; e < 8; e++) part[eg * 8 + e] = dot16_fp8(w[e], hx);
          __builtin_amdgcn_sched_barrier(0);
        }
        const float p1 = reduce16(part, b5, b4, b3, b2);
        sW[head * 64 + lane] = p.pgate[(size_t)t * 128 + head * 16 + me] * gelu_tanh(p1 * (1.f / PU_SCALE)) * (1.f / PV_SCALE);
        __builtin_amdgcn_sched_barrier(0);
      }
    }
#pragma unroll 1
    for (int head = 0; head < 8; head += (V_FP4 ? 2 : 1)) {
      const int myidx = p.pidx[(size_t)t * 128 + head * 16 + (lane & 31)];
      const float wgh = sW[head * 64 + lane];
      if (V_FP4) {
        const float wgh1 = sW[(head + 1) * 64 + lane];
        uint2 w[32];
#pragma unroll
        for (int e = 0; e < 32; e++) {
          const int idx = __builtin_amdgcn_readlane(myidx, e);
          w[e] = *(const uint2*)(PV + (size_t)idx * 512 + lane * 8);
        }
        __builtin_amdgcn_sched_barrier(0);
#pragma unroll
        for (int e = 0; e < 32; e++) {
          const float c = __uint_as_float(__builtin_amdgcn_readlane(__float_as_uint(e < 16 ? wgh : wgh1), 4 * (e & 15)));
          axpy16_fp4(w[e], c, acc2);
        }
      } else {
        uint4 w[16];
#pragma unroll
        for (int e = 0; e < 16; e++) {
          const int idx = __builtin_amdgcn_readlane(myidx, e);
          w[e] = *(const uint4*)(PV + (size_t)idx * 1024 + lane * 16);
        }
        __builtin_amdgcn_sched_barrier(0);
#pragma unroll
        for (int e = 0; e < 16; e++) {
          const float c = __uint_as_float(__builtin_amdgcn_readlane(__float_as_uint(wgh), 4 * e));
          axpy16_fp8(w[e], c, acc);
        }
      }
      __builtin_amdgcn_sched_barrier(0);
    }
    if (V_FP4) {
#pragma unroll
      for (int j = 0; j < 8; j++) { acc[2 * j] = acc2[j][0]; acc[2 * j + 1] = acc2[j][1]; }
    }
    float xv[16];
    load_row16<true>(p.xmid + (size_t)t * DM, lane, xv);
    const float* m = p.mod + ((size_t)l * 5 + cond_of(t)) * 6144 + 5120 + lane * 16;
#pragma unroll
    for (int q = 0; q < 4; q++) {
      const float4 g = *(const float4*)(m + 4 * q);
      xv[4 * q] += g.x * acc[4 * q]; xv[4 * q + 1] += g.y * acc[4 * q + 1];
      xv[4 * q + 2] += g.z * acc[4 * q + 2]; xv[4 * q + 3] += g.w * acc[4 * q + 3];
    }
    if (l == 0) {
#pragma unroll
      for (int q = 0; q < 4; q++)
        *(float4*)(p.x + (size_t)t * DM + lane * 16 + 4 * q) = make_float4(xv[4 * q], xv[4 * q + 1], xv[4 * q + 2], xv[4 * q + 3]);
      const float* m1 = p.mod + ((size_t)1 * 5 + cond_of(t)) * 6144;
      norm_emit<true>(xv, lane, p.in[9] + DM, m1 + 1024, m1, p.h, t, nullptr);
    } else {
      norm_emit<true>(xv, lane, p.in[32], nullptr, nullptr, nullptr, 0, p.out + (size_t)t * DM);
    }
  }
}

template <int S>
__device__ __forceinline__ void run_stage(const Params& p, int l, char* smem, const Blk& bk) {
  if (S == 0) ph_prologue(p, smem);
  else if (S == 1) ph_norm(p, 0, 0);
  else if (S == 2) ph_gemm_in(p, l, smem, bk);
  else if (S == 3) ph_mixers(p, l, smem);
  else if (S == 4) ph_attn(p, l, smem);
  else if (S == 5) ph_merge(p, l, smem, bk);
  else if (S == 6) ph_out(p, l, smem, bk);
  else if (S == 7) ph_norm(p, l, 1);
  else if (S == 8) ph_peer_q(p, l, smem, bk);
  else if (S == 9) ph_route(p, l, smem);
  else if (S == 10) ph_gather(p, l, smem);
  else if (S == 11) ph_combine(p, l);
}

template <int S>
__global__ void __launch_bounds__(256, 2) k_stage(Params p, int l) {
  __shared__ __align__(16) char smem[SMEM_BYTES];
  Blk bk; bk.xcd = blockIdx.x & 7; bk.rank = blockIdx.x >> 3; bk.nblk = gridDim.x >> 3;
  run_stage<S>(p, l, smem, bk);
}

__device__ __forceinline__ unsigned at_ld(unsigned* p) { return __hip_atomic_load(p, __ATOMIC_RELAXED, __HIP_MEMORY_SCOPE_AGENT); }
__device__ __forceinline__ unsigned at_add(unsigned* p, unsigned v) { return __hip_atomic_fetch_add(p, v, __ATOMIC_RELAXED, __HIP_MEMORY_SCOPE_AGENT); }
__device__ __forceinline__ void gbar(unsigned* base, int xcd, unsigned nblk_x, unsigned k, bool phys = false) {
  asm volatile("s_waitcnt vmcnt(0)" ::: "memory");
  __syncthreads();
  if (threadIdx.x == 0) {
    if (!phys) {
      __builtin_amdgcn_fence(__ATOMIC_RELEASE, "agent");
      asm volatile("s_waitcnt vmcnt(0)" ::: "memory");
    }
    unsigned* xarr = base + 64 * (1 + xcd);
    unsigned* xgen = base + 64 * (9 + xcd);
    const unsigned prev = at_add(xarr, 1u);
    if (prev == k * nblk_x - 1u) {
      if (phys) {
        __builtin_amdgcn_fence(__ATOMIC_RELEASE, "agent");
        asm volatile("s_waitcnt vmcnt(0)" ::: "memory");
      }
      at_add(base, 1u);
      while (at_ld(base) < 8u * k) __builtin_amdgcn_s_sleep(1);
      __hip_atomic_store(xgen, k, __ATOMIC_RELAXED, __HIP_MEMORY_SCOPE_AGENT);
    } else {
      while (at_ld(xgen) < k) __builtin_amdgcn_s_sleep(2);
    }
    __builtin_amdgcn_fence(__ATOMIC_ACQUIRE, "agent");
    asm volatile("s_waitcnt vmcnt(0)" ::: "memory");
  }
  __syncthreads();
}
#define STAGE(S, L) for (int r_ = 0; r_ < p.reps[S]; r_++) { run_stage<S>(p, L, smem, bk); epoch += 1; gbar(bctr, bk.xcd, (unsigned)bk.nblk, epoch, phys); }
template <int L>
__device__ __forceinline__ void run_layer(const Params& p, char* smem, unsigned* bctr, unsigned& epoch, const Blk& bk, const bool phys) {
  STAGE(2, L) STAGE(3, L) STAGE(4, L) STAGE(11, L) STAGE(5, L) STAGE(6, L) STAGE(7, L) STAGE(8, L) STAGE(9, L) STAGE(10, L)
}
__global__ void __launch_bounds__(256, 2) mega(Params p) {
  __shared__ __align__(16) char smem[SMEM_BYTES];
  cg::grid_group grid = cg::this_grid();
  Blk bk;
  {
    int* sI = (int*)smem;
    if (threadIdx.x == 0) {
      const int x = (int)(__builtin_amdgcn_s_getreg((3 << 11) | 20) & 7u);
      sI[0] = x;
      sI[1] = atomicAdd(&p.xcnt[x], 1);
    }
    __syncthreads();
    bk.xcd = __builtin_amdgcn_readfirstlane(sI[0]);
    bk.rank = __builtin_amdgcn_readfirstlane(sI[1]);
    bk.nblk = 0;
    __syncthreads();
  }
  unsigned* bctr = (unsigned*)p.xcnt + 64;
  unsigned epoch = 0;
  bool phys = false;
  {
    const Blk bk0 = {0, 0, 1};
    run_stage<0>(p, 0, smem, bk0);
    if (p.reps[0] < 0) grid.sync();
    gbar(bctr + 64 * 40, (int)(blockIdx.x & 7), gridDim.x >> 3, 1u);
  }
  {
    int mine = 0, mn = 1 << 30, tot = 0;
#pragma unroll
    for (int x = 0; x < 8; x++) {
      const int c = __hip_atomic_load(&p.xcnt[x], __ATOMIC_RELAXED, __HIP_MEMORY_SCOPE_AGENT);
      mine = (x == bk.xcd) ? c : mine;
      mn = c < mn ? c : mn;
      tot += c;
    }
    phys = mn > 0 && tot == (int)gridDim.x;
    if (phys) bk.nblk = mine;
    else { bk.xcd = blockIdx.x & 7; bk.rank = blockIdx.x >> 3; bk.nblk = gridDim.x >> 3; }
  }
  STAGE(1, 0)
  run_layer<0>(p, smem, bctr, epoch, bk, phys);
  run_layer<1>(p, smem, bctr, epoch, bk, phys);
}

extern "C" void kernel_launch(void* const* d_in, const int* in_sizes, int n_in, void* d_out, int out_size, void* d_ws,
                              size_t ws_size, hipStream_t stream) {
  Params p;
  memset(&p, 0, sizeof(p));
  for (int i = 0; i < 33; i++) p.in[i] = (const float*)d_in[i];
  p.out = (float*)d_out;
  char* w = (char*)d_ws;
  size_t off = 0;
  auto alloc = [&](size_t bytes) { char* r = w + off; off += (bytes + 255) & ~(size_t)255; return r; };
  p.WtIn = (u16*)alloc((size_t)2 * INW * 1024 * 2);
  p.WtUpA = (u16*)alloc((size_t)2 * 524288 * 2);
  p.WtUpB = (u16*)alloc((size_t)2 * 524288 * 2);
  p.WtUpC = (u16*)alloc((size_t)2 * 524288 * 2);
  p.WtOut = (u16*)alloc((size_t)2 * 1048576 * 2);
  p.WtQ = (u16*)alloc((size_t)2 * 2097152 * 2);
  p.KeysB = (u16*)alloc((size_t)2 * 32768 * 2);
  p.AwsB = (u16*)alloc((size_t)2 * 65536 * 2);
  p.LruWt = (u16*)alloc((size_t)2 * 131072 * 2);
  p.PU = (u16*)alloc((size_t)2 * 16384 * 1024);
  p.PV = (u16*)alloc((size_t)2 * 16384 * 1024);
  p.mod = (float*)alloc((size_t)2 * 5 * 6144 * 4);
  p.rope = (float*)alloc((size_t)3072 * 4);
  p.lam = (float*)alloc(256);
  p.x = (float*)alloc((size_t)T_ALL * DM * 4);
  p.h = (u16*)alloc((size_t)T_ALL * DM * 2);
  p.proj = (u16*)alloc((size_t)T_ALL * INW * 2);
  p.hs = (u16*)alloc((size_t)2 * T_ALL * 512 * 2);
  p.ya = (u16*)alloc((size_t)T_ALL * 512 * 2);
  p.yc = (u16*)alloc((size_t)T_ALL * 512 * 2);
  p.Qb = (u16*)alloc((size_t)T_ALL * 512 * 2);
  p.Kb = (u16*)alloc((size_t)7340032 * 2);
  p.Vt = (u16*)alloc((size_t)7340032 * 2);
  p.pidx = (int*)alloc((size_t)T_ALL * 128 * 4);
  p.pgate = (float*)alloc((size_t)T_ALL * 128 * 4);
  p.acum = (u16*)alloc((size_t)2 * T_ALL * 512 * 2);
  p.segtot = (float*)alloc((size_t)4 * 2 * 8 * 2 * 512 * 4);
  p.xcnt = (int*)alloc(16384);
  hipMemsetAsync(p.xcnt, 0, 16384, stream);
  p.yb = (u16*)p.pidx;
  p.xmid = (float*)((char*)p.proj + ((size_t)64 << 20));
  { const int reps[12] = {1, 1, 1, 1, 1, 1, 1, 1, 1, 1, 1, 1}; for (int i = 0; i < 12; i++) p.reps[i] = reps[i]; }
  if (off > ws_size) fprintf(stderr, "workspace too small: need %zu have %zu\n", off, ws_size);
  static int grid_blocks = 0;
  if (!grid_blocks) {
    int dev = 0, cus = 0, per_cu = 0;
    hipGetDevice(&dev);
    hipDeviceGetAttribute(&cus, hipDeviceAttributeMultiprocessorCount, dev);
    hipOccupancyMaxActiveBlocksPerMultiprocessor(&per_cu, mega, 256, 0);
    if (per_cu > 2) per_cu = 2;
    grid_blocks = cus * per_cu;
  }
  void* args[] = {&p};
  hipError_t e = hipLaunchCooperativeKernel((void*)mega, dim3(grid_blocks), dim3(256), args, 0, stream);
  if (e != hipSuccess) fprintf(stderr, "cooperative launch failed: %s (grid %d)\n", hipGetErrorString(e), grid_blocks);
}
```

```cpp
#include <hip/hip_runtime.h>
#include <hip/hip_cooperative_groups.h>
#include <cstdio>
#include <cstdint>
#include <cstring>
namespace cg = cooperative_groups;

typedef unsigned short u16;
typedef __attribute__((ext_vector_type(8))) short bf16x8;
typedef __attribute__((ext_vector_type(16))) float f32x16;

constexpr int T_CTX = 4096, T_ALL = 12288, DM = 1024, INW = 6656;
constexpr int OUT_YS = 4194304, OUT_K = 12582912, OUT_V = 16777216, OUT_LRU = 20971520;
constexpr int SMEM_BYTES = 75776;
constexpr int NPHASE = 20;

struct Params {
  const float* in[33];
  float* out;
  u16 *WtIn, *WtUpA, *WtUpB, *WtUpC, *WtOut, *WtQ, *KeysB, *AwsB, *LruWt, *PU, *PV;
  float *mod, *rope, *lam, *x;
  u16 *h, *proj, *hs, *ya, *yc, *Qb, *Kb, *Vt;
  int* pidx;
  float* pgate;
  u16* yb;
  float* xmid;
  int reps[12];
  int* xcnt;
  u16* acum;
  float* segtot;
};
struct Blk { int xcd, rank, nblk; };


typedef float f32x2_ __attribute__((ext_vector_type(2)));
typedef __bf16 bf16x2_ __attribute__((ext_vector_type(2)));
__device__ __forceinline__ uint32_t pack2(float a, float b) {
  f32x2_ v = {a, b};
  bf16x2_ r = __builtin_convertvector(v, bf16x2_);
  return __builtin_bit_cast(uint32_t, r);
}
__device__ __forceinline__ u16 f2bf(float f) { return (u16)(pack2(f, 0.f) & 0xffffu); }
__device__ __forceinline__ float bf2f(u16 h) { return __uint_as_float(((uint32_t)h) << 16); }
__device__ __forceinline__ float lo2f(uint32_t w) { return __uint_as_float(w << 16); }
__device__ __forceinline__ float hi2f(uint32_t w) { return __uint_as_float(w & 0xffff0000u); }
__device__ __forceinline__ float sigmoidf_(float x) { return __builtin_amdgcn_rcpf(1.f + __expf(-x)); }
__device__ __forceinline__ float gelu_tanh(float x) {
  float u = 0.7978845608028654f * (x + 0.044715f * x * x * x);
  return x * sigmoidf_(2.f * u);
}
__device__ __forceinline__ float wave_sum(float v) {
#pragma unroll
  for (int o = 32; o >= 1; o >>= 1) v += __shfl_xor(v, o);
  return v;
}
__device__ __forceinline__ int get_tid() {
  int t;
  asm volatile("v_mov_b32 %0, %1" : "=v"(t) : "v"((int)threadIdx.x));
  return t;
}
__device__ __forceinline__ size_t blk_off(int t, int c) { return (size_t)(c >> 6) * ((size_t)T_ALL * 64) + (size_t)t * 64 + (c & 63); }
__device__ __forceinline__ const float* in_xrow(const float* xp, const float* xs, int t) {
  return t < T_CTX ? xp + (size_t)t * DM : xs + (size_t)(t - T_CTX) * DM;
}
__device__ __forceinline__ int cond_of(int t) { return t < T_CTX ? 0 : 1 + ((t - T_CTX) >> 11); }
__device__ __forceinline__ float lam_init_of(int l) { return l == 0 ? 0.2f : 0.35550906759f; }

constexpr int LDS_STRIDE = 72;
typedef uint32_t u32x4 __attribute__((ext_vector_type(4)));
__device__ __forceinline__ void gl16(u32x4& r, const u16* p) {
  asm volatile("global_load_dwordx4 %0, %1, off" : "=v"(r) : "v"(p));
}
#define GLDS16(gptr, lptr) \
  __builtin_amdgcn_global_load_lds((const unsigned*)(gptr), (__attribute__((address_space(3))) unsigned*)(lptr), 16, 0, 0)
template <int NJ>
__device__ __forceinline__ void gemm_core(const u16* __restrict__ A, size_t ksA, const u16* __restrict__ Bt, size_t ksB, int K,
                                          f32x16 (&acc)[2][NJ], u16* sA, u16*  ) {
  constexpr int A_BYTES = 16384, B_BYTES = 8192 * NJ, STG_BYTES = A_BYTES + B_BYTES;
  char* lds = (char*)sA;
  const int tid = get_tid(), lane = tid & 63, wave = tid >> 6;
  const int wm = wave >> 1, wn = wave & 1;
  const int r = lane & 31, hh = lane >> 5;
  const int srcoff = (tid >> 3) * 64 + (((tid & 7) ^ ((tid >> 4) & 7)) * 8);
  const u16* ga = A + srcoff;
  const u16* gb = Bt + srcoff;
  char* la = lds + tid * 16;
#define GEMM_ISSUE(STG)                                                                                        \
  {                                                                                                            \
    char* l_ = la + (STG) * STG_BYTES;                                                                         \
    GLDS16(ga, l_); GLDS16(ga + 2048, l_ + 4096); GLDS16(ga + 4096, l_ + 8192); GLDS16(ga + 6144, l_ + 12288); \
    GLDS16(gb, l_ + A_BYTES); GLDS16(gb + 2048, l_ + A_BYTES + 4096);                                          \
    if (NJ == 2) { GLDS16(gb + 4096, l_ + A_BYTES + 8192); GLDS16(gb + 6144, l_ + A_BYTES + 12288); }          \
    ga += ksA; gb += ksB;                                                                                      \
  }
  const int nk = K >> 6;
  const int rswz = (r >> 1) & 7;
  const char* ra = lds + (wm * 64 + r) * 128;
  const char* rb = lds + A_BYTES + (wn * 32 * NJ + r) * 128;
  constexpr int NS = (NJ == 1) ? 3 : 2;
  if (NS == 3) asm volatile("s_waitcnt vmcnt(0)" ::: "memory");
  __syncthreads();
  GEMM_ISSUE(0)
  if (NS == 3) GEMM_ISSUE(1)
  int cs = 0;
  for (int kb = 0; kb < nk; kb++) {
    int cur;
    if (NS == 3) {
      if (kb + 1 < nk) asm volatile("s_waitcnt vmcnt(6)" ::: "memory");
      else asm volatile("s_waitcnt vmcnt(0)" ::: "memory");
      __builtin_amdgcn_s_barrier();
      asm volatile("" ::: "memory");
      cur = cs * STG_BYTES;
      const int ns = cs >= 1 ? cs - 1 : 2;
      if (kb + 2 < nk) GEMM_ISSUE(ns)
      cs = cs == 2 ? 0 : cs + 1;
    } else {
      asm volatile("s_waitcnt vmcnt(0)" ::: "memory");
      __builtin_amdgcn_s_barrier();
      asm volatile("" ::: "memory");
      cur = (kb & 1) * STG_BYTES;
      if (kb + 1 < nk) {
        if (kb & 1) GEMM_ISSUE(0) else GEMM_ISSUE(1)
      }
    }
    __builtin_amdgcn_sched_barrier(0);
    __builtin_amdgcn_s_setprio(1);
#pragma unroll
    for (int ks = 0; ks < 4; ks++) {
      const int co = (((ks * 2 + hh) ^ rswz) << 4) + cur;
      bf16x8 a[2], b[NJ];
#pragma unroll
      for (int i = 0; i < 2; i++) a[i] = *(const bf16x8*)(ra + i * 4096 + co);
#pragma unroll
      for (int j = 0; j < NJ; j++) b[j] = *(const bf16x8*)(rb + j * 4096 + co);
#pragma unroll
      for (int i = 0; i < 2; i++)
#pragma unroll
        for (int j = 0; j < NJ; j++) acc[i][j] = __builtin_amdgcn_mfma_f32_32x32x16_bf16(a[i], b[j], acc[i][j], 0, 0, 0);
    }
    __builtin_amdgcn_s_setprio(0);
  }
#undef GEMM_ISSUE
}
#define ACC_ZERO(acc)                                   \
  _Pragma("unroll") for (int i_ = 0; i_ < 2; i_++)      \
  _Pragma("unroll") for (int j_ = 0; j_ < 2; j_++)      \
  _Pragma("unroll") for (int r_ = 0; r_ < 16; r_++) acc[i_][j_][r_] = 0.f;
#define ACC_ROW(wm, i, r, lane) ((wm) * 64 + (i) * 32 + ((r) & 3) + 8 * ((r) >> 2) + 4 * ((lane) >> 5))
#define ACC_COL(wn, j, lane) ((wn) * 64 + (j) * 32 + ((lane) & 31))

template <int NJ>
__device__ __forceinline__ void stage_tile_bf16(const f32x16 (&acc)[2][NJ], u16* sC, int wm, int wn, int lane) {
  constexpr int CS = 64 * NJ + 8;
#pragma unroll
  for (int i = 0; i < 2; i++)
#pragma unroll
    for (int j = 0; j < NJ; j++)
#pragma unroll
      for (int r = 0; r < 16; r++)
        sC[(wm * 64 + i * 32 + (r & 3) + 8 * (r >> 2) + 4 * (lane >> 5)) * CS + wn * 32 * NJ + j * 32 + (lane & 31)] = f2bf(acc[i][j][r]);
}
template <bool CONTIG = false>
__device__ __forceinline__ void norm_emit(const float (&xv)[16], int lane, const float* __restrict__ gain,
                                          const float* __restrict__ sc, const float* __restrict__ sh, u16* hdst, int t, float* fdst) {
  float ss = 0.f;
#pragma unroll
  for (int e = 0; e < 16; e++) ss += xv[e] * xv[e];
  ss = wave_sum(ss);
  const float rstd = rsqrtf(ss * (1.f / 1024.f) + 1e-6f);
#pragma unroll
  for (int i = 0; i < 2; i++) {
    const int c0 = CONTIG ? lane * 16 + i * 8 : i * 512 + lane * 8;
    float y[8];
#pragma unroll
    for (int j = 0; j < 8; j++) {
      float v = xv[i * 8 + j] * rstd * gain[c0 + j];
      if (sc) v = v * (1.f + sc[c0 + j]) + sh[c0 + j];
      y[j] = v;
    }
    if (hdst) {
      uint4 o;
      o.x = pack2(y[0], y[1]); o.y = pack2(y[2], y[3]); o.z = pack2(y[4], y[5]); o.w = pack2(y[6], y[7]);
      *(uint4*)(hdst + blk_off(t, c0)) = o;
    } else {
      *(float4*)(fdst + c0) = make_float4(y[0], y[1], y[2], y[3]);
      *(float4*)(fdst + c0 + 4) = make_float4(y[4], y[5], y[6], y[7]);
    }
  }
}
template <bool CONTIG = false>
__device__ __forceinline__ void load_row16(const float* __restrict__ xr, int lane, float (&xv)[16]) {
#pragma unroll
  for (int i = 0; i < 2; i++) {
    const int c0 = CONTIG ? lane * 16 + i * 8 : i * 512 + lane * 8;
    float4 a = *(const float4*)(xr + c0);
    float4 b = *(const float4*)(xr + c0 + 4);
    xv[i * 8 + 0] = a.x; xv[i * 8 + 1] = a.y; xv[i * 8 + 2] = a.z; xv[i * 8 + 3] = a.w;
    xv[i * 8 + 4] = b.x; xv[i * 8 + 5] = b.y; xv[i * 8 + 6] = b.z; xv[i * 8 + 7] = b.w;
  }
}

__device__ void tr_tile(const float* __restrict__ src, int R, int C, u16* __restrict__ dst, int tr, int tc, float* sT) {
  const int tid = get_tid();
  const int r0 = tr * 64, c0 = tc * 64;
  __syncthreads();
#pragma unroll
  for (int i = 0; i < 4; i++) {
    int r = (tid >> 4) + 16 * i, c4 = (tid & 15) * 4;
    float4 v = *(const float4*)(src + (size_t)(r0 + r) * C + c0 + c4);
    sT[r * 65 + c4 + 0] = v.x; sT[r * 65 + c4 + 1] = v.y; sT[r * 65 + c4 + 2] = v.z; sT[r * 65 + c4 + 3] = v.w;
  }
  __syncthreads();
  const int c = tid >> 2, rq = (tid & 3) * 16;
  uint32_t w[8];
#pragma unroll
  for (int j = 0; j < 8; j++) w[j] = pack2(sT[(rq + 2 * j) * 65 + c], sT[(rq + 2 * j + 1) * 65 + c]);
  u16* d = dst + (size_t)tr * C * 64 + (size_t)(c0 + c) * 64 + rq;
  *(uint4*)(d) = make_uint4(w[0], w[1], w[2], w[3]);
  *(uint4*)(d + 8) = make_uint4(w[4], w[5], w[6], w[7]);
}
__device__ __forceinline__ void cvt_item(const float* __restrict__ src, u16* __restrict__ dst, size_t item) {
  size_t o = item * 2048 + (size_t)get_tid() * 8;
  float4 a = *(const float4*)(src + o), b = *(const float4*)(src + o + 4);
  *(uint4*)(dst + o) = make_uint4(pack2(a.x, a.y), pack2(a.z, a.w), pack2(b.x, b.y), pack2(b.z, b.w));
}

typedef float f32x2 __attribute__((ext_vector_type(2)));
__device__ __forceinline__ void cvt8_item(const float* __restrict__ src, unsigned char* __restrict__ dst, size_t item, float scale) {
  const size_t o = item * 8192 + (size_t)get_tid() * 8;
  float4 a[4], b[4];
#pragma unroll
  for (int q = 0; q < 4; q++) { a[q] = *(const float4*)(src + o + q * 2048); b[q] = *(const float4*)(src + o + q * 2048 + 4); }
#pragma unroll
  for (int q = 0; q < 4; q++) {
    int w0 = __builtin_amdgcn_cvt_pk_fp8_f32(a[q].x * scale, a[q].y * scale, 0, false);
    w0 = __builtin_amdgcn_cvt_pk_fp8_f32(a[q].z * scale, a[q].w * scale, w0, true);
    int w1 = __builtin_amdgcn_cvt_pk_fp8_f32(b[q].x * scale, b[q].y * scale, 0, false);
    w1 = __builtin_amdgcn_cvt_pk_fp8_f32(b[q].z * scale, b[q].w * scale, w1, true);
    *(uint2*)(dst + o + q * 2048) = make_uint2((uint32_t)w0, (uint32_t)w1);
  }
}
__device__ __forceinline__ void cvt4_item(const float* __restrict__ src, unsigned char* __restrict__ dst, size_t item, float scale) {
  const size_t o = item * 8192 + (size_t)get_tid() * 8;
  float4 a[4], b[4];
#pragma unroll
  for (int q = 0; q < 4; q++) { a[q] = *(const float4*)(src + o + q * 2048); b[q] = *(const float4*)(src + o + q * 2048 + 4); }
#pragma unroll
  for (int q = 0; q < 4; q++) {
    unsigned w = 0;
    w = __builtin_amdgcn_cvt_scalef32_pk_fp4_f32(w, a[q].x * scale, a[q].y * scale, 1.0f, 0);
    w = __builtin_amdgcn_cvt_scalef32_pk_fp4_f32(w, a[q].z * scale, a[q].w * scale, 1.0f, 1);
    w = __builtin_amdgcn_cvt_scalef32_pk_fp4_f32(w, b[q].x * scale, b[q].y * scale, 1.0f, 2);
    w = __builtin_amdgcn_cvt_scalef32_pk_fp4_f32(w, b[q].z * scale, b[q].w * scale, 1.0f, 3);
    *(uint32_t*)(dst + ((o + q * 2048) >> 1)) = w;
  }
}
constexpr bool U_FP4 = true, V_FP4 = true;
constexpr float PU_SCALE = U_FP4 ? 48.f : 64.f, PV_SCALE = V_FP4 ? 6.f : 8.f;
constexpr int PU_ROWB = U_FP4 ? 512 : 1024, PV_ROWB = V_FP4 ? 512 : 1024;
__device__ void ph_prologue(const Params& p, char* smem) {
  const int tid = get_tid();
  float* sf = (float*)smem;
  constexpr int N_MODI = 192, N_MISC = 1, N_TR = 5696, N_KEYS = 32, N_AWS = 64, N_X = 0, N_PU = 4096, N_PV = 4096;
  constexpr int B_MISC = N_MODI, B_TR = B_MISC + N_MISC, B_KEYS = B_TR + N_TR, B_AWS = B_KEYS + N_KEYS, B_X = B_AWS + N_AWS,
                B_PU = B_X + N_X, B_PV = B_PU + N_PU, N_TOTAL = B_PV + N_PV;
  for (int it = blockIdx.x; it < N_TOTAL; it += gridDim.x) {
    if (it < N_MODI) {
      const int l = it / 96, n0 = (it % 96) * 64;
      __syncthreads();
      for (int e = tid; e < 5 * 1024; e += 256) {
        int c = e >> 10, k = e & 1023;
        float v = (c == 0) ? p.in[6][k] : p.in[5][(c - 1) * 1024 + k];
        sf[e] = v * sigmoidf_(v);
      }
      __syncthreads();
      const int col4 = (tid & 15) * 4, kg = tid >> 4;
      const float* w = p.in[7] + (size_t)l * 1024 * 6144 + n0 + col4;
      float a[5][4];
#pragma unroll
      for (int c = 0; c < 5; c++)
#pragma unroll
        for (int q = 0; q < 4; q++) a[c][q] = 0.f;
#pragma unroll 8
      for (int k = kg * 64; k < kg * 64 + 64; k++) {
        const float4 wv = *(const float4*)(w + (size_t)k * 6144);
#pragma unroll
        for (int c = 0; c < 5; c++) {
          const float sv = sf[c * 1024 + k];
          a[c][0] += sv * wv.x; a[c][1] += sv * wv.y; a[c][2] += sv * wv.z; a[c][3] += sv * wv.w;
        }
      }
      float* sr = sf + 5120;
#pragma unroll
      for (int c = 0; c < 5; c++)
#pragma unroll
        for (int q = 0; q < 4; q++) sr[(kg * 5 + c) * 64 + col4 + q] = a[c][q];
      __syncthreads();
      for (int e = tid; e < 320; e += 256) {
        int c = e >> 6, cc = e & 63;
        float sm = 0.f;
#pragma unroll
        for (int g = 0; g < 16; g++) sm += sr[(g * 5 + c) * 64 + cc];
        p.mod[((size_t)l * 5 + c) * 6144 + n0 + cc] = sm + p.in[8][l * 6144 + n0 + cc];
      }
    } else if (it < B_TR) {
      for (int e = tid; e < 1536; e += 256) {
        int pos, f;
        if (e < 512) { pos = e >> 4; f = e & 15; } else { pos = (e - 512) >> 4; f = (e - 512) & 15; }
        float inv = powf(10000.f, -(float)f / 16.f);
        float ang = (float)pos * inv;
        p.rope[2 * e] = cosf(ang);
        p.rope[2 * e + 1] = sinf(ang);
      }
      if (tid < 128) {
        int l = tid >> 6, i = tid & 63;
        const float* lp = p.in[22] + l * 256;
        float s1 = wave_sum(lp[i] * lp[64 + i]);
        float s2 = wave_sum(lp[128 + i] * lp[192 + i]);
        if (i == 0) p.lam[l] = expf(s1) - expf(s2) + lam_init_of(l);
      }
    } else if (it < B_KEYS) {
      int j = it - B_TR;
      const int l = j / 2848; j -= l * 2848;
      if (j < 1664) tr_tile(p.in[11] + (size_t)l * 1024 * INW, 1024, INW, p.WtIn + (size_t)l * INW * 1024, j / 104, j % 104, sf);
      else if (j < 1792) { j -= 1664; tr_tile(p.in[24] + (size_t)l * 524288, 512, 1024, p.WtUpA + (size_t)l * 524288, j / 16, j % 16, sf); }
      else if (j < 1920) { j -= 1792; tr_tile(p.in[25] + (size_t)l * 524288, 512, 1024, p.WtUpB + (size_t)l * 524288, j / 16, j % 16, sf); }
      else if (j < 2048) { j -= 1920; tr_tile(p.in[26] + (size_t)l * 524288, 512, 1024, p.WtUpC + (size_t)l * 524288, j / 16, j % 16, sf); }
      else if (j < 2304) { j -= 2048; tr_tile(p.in[27] + (size_t)l * 1048576, 1024, 1024, p.WtOut + (size_t)l * 1048576, j / 16, j % 16, sf); }
      else if (j < 2816) { j -= 2304; tr_tile(p.in[28] + (size_t)l * 2097152, 1024, 2048, p.WtQ + (size_t)l * 2097152, j / 32, j % 32, sf); }
      else {
        j -= 2816;
        const int ri = j >> 4, dh = j & 15;
        tr_tile(p.in[ri ? 19 : 17] + (size_t)l * 65536 + dh * 4096, 64, 64, p.LruWt + (size_t)l * 131072 + (ri * 16 + dh) * 4096, 0, 0, sf);
      }
    } else if (it < B_AWS) {
      cvt_item(p.in[29], p.KeysB, it - B_KEYS);
    } else if (it < B_X) {
      cvt_item(p.in[13], p.AwsB, it - B_AWS);
    } else if (it < B_PV) {
      if (U_FP4) cvt4_item(p.in[30], (unsigned char*)p.PU, it - B_PU, PU_SCALE);
      else cvt8_item(p.in[30], (unsigned char*)p.PU, it - B_PU, PU_SCALE);
    } else {
      if (V_FP4) cvt4_item(p.in[31], (unsigned char*)p.PV, it - B_PV, PV_SCALE);
      else cvt8_item(p.in[31], (unsigned char*)p.PV, it - B_PV, PV_SCALE);
    }
  }
}

__device__ void ph_norm(const Params& p, int l, int which) {
  const int tid_ = get_tid(), lane = tid_ & 63, wave = tid_ >> 6;
  for (int t = blockIdx.x * 4 + wave; t < T_ALL; t += gridDim.x * 4) {
    float xv[16];
    load_row16(which == 0 ? in_xrow(p.in[0], p.in[1], t) : p.xmid + (size_t)t * DM, lane, xv);
    const float* m = p.mod + ((size_t)l * 5 + cond_of(t)) * 6144;
    if (which == 0) norm_emit(xv, lane, p.in[9] + l * DM, m + 1024, m, p.h, t, nullptr);
    else norm_emit(xv, lane, p.in[10] + l * DM, m + 4096, m + 3072, p.h, t, nullptr);
  }
}

__device__ void ph_gemm_in(const Params& p, int l, char* smem, const Blk& bk) {
  u16* sA = (u16*)smem; u16* sB = sA + 2 * 128 * LDS_STRIDE;
  const int tid_ = get_tid(), lane = tid_ & 63, wave = tid_ >> 6, wm = wave >> 1, wn = wave & 1;
  constexpr int NT = INW / 128;
  const int xcd = bk.xcd;
  for (int lt = bk.rank; lt < 12 * NT; lt += bk.nblk) {
    const int mt = xcd * 12 + lt % 12, nt = lt / 12;
    f32x16 acc[2][2];
    ACC_ZERO(acc);
    gemm_core<2>(p.h + (size_t)mt * 128 * 64, (size_t)T_ALL * 64, p.WtIn + (size_t)l * INW * DM + (size_t)nt * 128 * 64, (size_t)INW * 64, DM, acc, sA, sB);
    __syncthreads();
    stage_tile_bf16<2>(acc, sA, wm, wn, lane);
    __syncthreads();
    {
      const int tid = wave * 64 + lane;
#pragma unroll
      for (int q = 0; q < 8; q++) {
        const int idx = tid + 256 * q, row = idx >> 4, ch = idx & 15;
        *(uint4*)(p.proj + (size_t)(mt * 128 + row) * INW + nt * 128 + ch * 8) = *(const uint4*)(sA + row * 136 + ch * 8);
      }
    }
    if (mt * 128 < T_CTX && nt * 128 >= 2560 && nt * 128 < 3584) {
      float* ob = p.out + (nt * 128 < 3072 ? OUT_K - 2560 : OUT_V - 3072);
#pragma unroll
      for (int i = 0; i < 2; i++)
#pragma unroll
        for (int j = 0; j < 2; j++) {
          const int n = nt * 128 + ACC_COL(wn, j, lane);
#pragma unroll
          for (int r = 0; r < 16; r++) {
            const int t = mt * 128 + ACC_ROW(wm, i, r, lane);
            const int b = t >> 8, sq = t & 255;
            ob[((size_t)(b * 2 + l) * 256 + sq) * 512 + n] = acc[i][j][r];
          }
        }
    }
  }
}

__device__ void item_chunk_mlp(const Params& p, int l, int chunk, int g, char* smem) {
  const int tid = get_tid(), lane = tid & 63, wave = tid >> 6, wm = wave >> 1, wn = wave & 1;
  u16* sVt = (u16*)smem;
  float* sR = (float*)(smem + 128 * 136 * 2);
  const int t0 = chunk * 128;
  __syncthreads();
  {
    const int q = tid >> 1, hf = tid & 1;
    const u16* vp = p.proj + (size_t)(t0 + q) * INW + 512 + hf * 256;
    float ss = 0.f;
#pragma unroll 4
    for (int i = 0; i < 32; i++) {
      uint4 w = *(const uint4*)(vp + i * 8);
      float a;
      a = lo2f(w.x); ss += a * a; a = hi2f(w.x); ss += a * a;
      a = lo2f(w.y); ss += a * a; a = hi2f(w.y); ss += a * a;
      a = lo2f(w.z); ss += a * a; a = hi2f(w.z); ss += a * a;
      a = lo2f(w.w); ss += a * a; a = hi2f(w.w); ss += a * a;
    }
    ss += __shfl_xor(ss, 1);
    if (hf == 0) sR[q] = rsqrtf(ss * (1.f / 512.f) + 1e-6f);
  }
  __syncthreads();
  {
    const int q = tid >> 1, cb = (tid & 1) * 64;
    const float rs = sR[q];
    const u16* vp = p.proj + (size_t)(t0 + q) * INW + 512 + g * 128 + cb;
    const float* gv = p.in[12] + l * 512 + g * 128 + cb;
#pragma unroll
    for (int i = 0; i < 8; i++) {
      uint4 w = *(const uint4*)(vp + i * 8);
      uint32_t ww[4] = {w.x, w.y, w.z, w.w};
#pragma unroll
      for (int j = 0; j < 4; j++) {
        int c = cb + i * 8 + 2 * j;
        sVt[c * 136 + q] = f2bf(lo2f(ww[j]) * rs * gv[i * 8 + 2 * j]);
        sVt[(c + 1) * 136 + q] = f2bf(hi2f(ww[j]) * rs * gv[i * 8 + 2 * j + 1]);
      }
    }
  }
  __syncthreads();
  const u16* Aw = p.AwsB + (size_t)l * 65536 + g * 16384;
  f32x16 acc[2][2];
  ACC_ZERO(acc);
#pragma unroll
  for (int ks = 0; ks < 8; ks++) {
    bf16x8 a[2], b[2];
#pragma unroll
    for (int i = 0; i < 2; i++) {
      a[i] = *(const bf16x8*)(Aw + (wm * 64 + i * 32 + (lane & 31)) * 128 + ks * 16 + (lane >> 5) * 8);
      b[i] = *(const bf16x8*)(sVt + (wn * 64 + i * 32 + (lane & 31)) * 136 + ks * 16 + (lane >> 5) * 8);
    }
#pragma unroll
    for (int i = 0; i < 2; i++)
#pragma unroll
      for (int j = 0; j < 2; j++) acc[i][j] = __builtin_amdgcn_mfma_f32_32x32x16_bf16(a[i], b[j], acc[i][j], 0, 0, 0);
  }
  __syncthreads();
  float* sM = (float*)smem;
#pragma unroll
  for (int i = 0; i < 2; i++)
#pragma unroll
    for (int j = 0; j < 2; j++)
#pragma unroll
      for (int r = 0; r < 16; r++) sM[ACC_ROW(wm, i, r, lane) * 132 + ACC_COL(wn, j, lane)] = acc[i][j][r];
  __syncthreads();
  {
    const int pp = tid >> 1, cb = (tid & 1) * 64;
    const float bsv = p.in[14][l * 512 + g * 128 + pp];
    const u16* up = p.proj + (size_t)(t0 + pp) * INW + g * 128 + cb;
    u16* yp = p.ya + blk_off(t0 + pp, g * 128 + cb);
    const float* mp = sM + pp * 132 + cb;
#pragma unroll 2
    for (int i = 0; i < 8; i++) {
      const uint4 w = *(const uint4*)(up + i * 8);
      const float4 m0 = *(const float4*)(mp + i * 8), m1 = *(const float4*)(mp + i * 8 + 4);
      uint4 o;
      o.x = pack2(lo2f(w.x) * (m0.x + bsv), hi2f(w.x) * (m0.y + bsv));
      o.y = pack2(lo2f(w.y) * (m0.z + bsv), hi2f(w.y) * (m0.w + bsv));
      o.z = pack2(lo2f(w.z) * (m1.x + bsv), hi2f(w.z) * (m1.y + bsv));
      o.w = pack2(lo2f(w.w) * (m1.z + bsv), hi2f(w.w) * (m1.w + bsv));
      *(uint4*)(yp + i * 8) = o;
    }
  }
}

__device__ void item_lru(const Params& p, int l, int seq, int seg, int d, int hb, char* smem) {
  const int tid = get_tid(), lane = tid & 63, wave = tid >> 6;
  float* sXf = (float*)smem;
  float* sA_ = sXf + 64 * 65;
  float* sBx = sA_ + 64 * 65;
  float* sPar = sBx + 64 * 65;
  u16* sXb = (u16*)(sPar + 512);
  const bool lat = seq >= 16;
  const int L = lat ? 2048 : 256;
  const int tok0 = lat ? T_CTX + (seq - 16) * 2048 : seq * 256;
  __syncthreads();
  if (tid < 64) {
    const int ch = hb * 64 + tid;
#pragma unroll
    for (int j = 0; j < 4; j++) sPar[j * 64 + tid] = p.in[15][l * 2048 + j * 512 + ch];
    sPar[256 + tid] = p.in[16][l * 512 + ch];
    const float lm = p.in[21][(l * 2 + d) * 512 + ch];
    sPar[320 + tid] = (-lm > 20.f) ? -lm : log1pf(expf(-lm));
    sPar[384 + tid] = p.in[18][(l * 2 + d) * 512 + ch];
    sPar[448 + tid] = p.in[20][(l * 2 + d) * 512 + ch];
  }
  const int th = wave & 1, nt = wave >> 1;
  bf16x8 wr[4], wi[4];
  {
    const u16* Wr = p.LruWt + (size_t)l * 131072 + ((0 * 2 + d) * 8 + hb) * 4096;
    const u16* Wi = p.LruWt + (size_t)l * 131072 + ((1 * 2 + d) * 8 + hb) * 4096;
#pragma unroll
    for (int ks = 0; ks < 4; ks++) {
      wr[ks] = *(const bf16x8*)(Wr + (nt * 32 + (lane & 31)) * 64 + ks * 16 + (lane >> 5) * 8);
      wi[ks] = *(const bf16x8*)(Wi + (nt * 32 + (lane & 31)) * 64 + ks * 16 + (lane >> 5) * 8);
    }
  }
  float hstate = 0.f, acum = 1.f;
  u16* acg = p.acum + (size_t)d * T_ALL * 512;
  u16* hs = p.hs + (size_t)d * T_ALL * 512;
  __syncthreads();
  const int r = tid >> 2, cq = (tid & 3) * 16;
  for (int ti = 0; ti < 4; ti++) {
    const int pos = seg * 256 + ti * 64 + r;
    const int ts = d == 0 ? pos : L - 1 - pos;
    {
      float xc[16];
#pragma unroll
      for (int c = 0; c < 16; c++) xc[c] = sPar[256 + cq + c];
#pragma unroll
      for (int j = 0; j < 4; j++) {
        const int tt = ts + j - 2;
        if (tt >= 0 && tt < L) {
          const u16* xp = p.proj + (size_t)(tok0 + tt) * INW + 1024 + hb * 64 + cq;
          uint4 w0 = *(const uint4*)xp, w1 = *(const uint4*)(xp + 8);
          uint32_t ww[8] = {w0.x, w0.y, w0.z, w0.w, w1.x, w1.y, w1.z, w1.w};
#pragma unroll
          for (int c = 0; c < 8; c++) {
            xc[2 * c] += lo2f(ww[c]) * sPar[j * 64 + cq + 2 * c];
            xc[2 * c + 1] += hi2f(ww[c]) * sPar[j * 64 + cq + 2 * c + 1];
          }
        }
      }
#pragma unroll
      for (int c = 0; c < 16; c++) sXf[r * 65 + cq + c] = xc[c];
      uint4 o0 = make_uint4(pack2(xc[0], xc[1]), pack2(xc[2], xc[3]), pack2(xc[4], xc[5]), pack2(xc[6], xc[7]));
      uint4 o1 = make_uint4(pack2(xc[8], xc[9]), pack2(xc[10], xc[11]), pack2(xc[12], xc[13]), pack2(xc[14], xc[15]));
      *(uint4*)(sXb + r * 72 + cq) = o0;
      *(uint4*)(sXb + r * 72 + cq + 8) = o1;
    }
    __syncthreads();
    {
      f32x16 ar, ai;
#pragma unroll
      for (int q = 0; q < 16; q++) { ar[q] = 0.f; ai[q] = 0.f; }
#pragma unroll
      for (int ks = 0; ks < 4; ks++) {
        bf16x8 a = *(const bf16x8*)(sXb + (th * 32 + (lane & 31)) * 72 + ks * 16 + (lane >> 5) * 8);
        ar = __builtin_amdgcn_mfma_f32_32x32x16_bf16(a, wr[ks], ar, 0, 0, 0);
        ai = __builtin_amdgcn_mfma_f32_32x32x16_bf16(a, wi[ks], ai, 0, 0, 0);
      }
      const int ch = nt * 32 + (lane & 31);
      const float sp = sPar[320 + ch], br_ = sPar[384 + ch], bi_ = sPar[448 + ch];
#pragma unroll
      for (int q = 0; q < 16; q++) {
        const int tk = th * 32 + (q & 3) + 8 * (q >> 2) + 4 * (lane >> 5);
        const float rr = sigmoidf_(ar[q] + br_), ii = sigmoidf_(ai[q] + bi_);
        const float la = -8.f * rr * sp;
        const float a = __expf(la);
        const float om = fmaxf(1.f - __expf(2.f * la), 0.f);
        sA_[tk * 65 + ch] = a;
        sBx[tk * 65 + ch] = __builtin_amdgcn_sqrtf(om) * ii * sXf[tk * 65 + ch];
      }
    }
    __syncthreads();
    if (tid < 64) {
#pragma unroll 8
      for (int q = 0; q < 64; q++) {
        const float a = sA_[q * 65 + tid];
        hstate = a * hstate + sBx[q * 65 + tid];
        acum *= a;
        sBx[q * 65 + tid] = hstate;
        sA_[q * 65 + tid] = acum;
      }
    }
    __syncthreads();
    {
      float v[16];
#pragma unroll
      for (int c = 0; c < 16; c++) v[c] = sBx[r * 65 + cq + c];
      u16* dp = hs + (size_t)(tok0 + ts) * 512 + hb * 64 + cq;
      *(uint4*)dp = make_uint4(pack2(v[0], v[1]), pack2(v[2], v[3]), pack2(v[4], v[5]), pack2(v[6], v[7]));
      *(uint4*)(dp + 8) = make_uint4(pack2(v[8], v[9]), pack2(v[10], v[11]), pack2(v[12], v[13]), pack2(v[14], v[15]));
      if (lat) {
#pragma unroll
        for (int c = 0; c < 16; c++) v[c] = sA_[r * 65 + cq + c];
        u16* ap = acg + (size_t)(tok0 + ts) * 512 + hb * 64 + cq;
        *(uint4*)ap = make_uint4(pack2(v[0], v[1]), pack2(v[2], v[3]), pack2(v[4], v[5]), pack2(v[6], v[7]));
        *(uint4*)(ap + 8) = make_uint4(pack2(v[8], v[9]), pack2(v[10], v[11]), pack2(v[12], v[13]), pack2(v[14], v[15]));
      }
    }
    __syncthreads();
  }
  if (tid < 64) {
    if (!lat) p.out[OUT_LRU + ((seq * 2 + l) * 2 + d) * 512 + hb * 64 + tid] = hstate;
    else {
      float* st = p.segtot + ((((size_t)(seq - 16) * 2 + d) * 8 + seg) * 2) * 512 + hb * 64 + tid;
      st[0] = acum;
      st[512] = hstate;
    }
  }
}

__device__ __forceinline__ size_t kv_base(int seq) { return seq < 16 ? (size_t)seq * 131072 : (size_t)2097152 + (size_t)(seq - 16) * 1310720; }
__device__ __forceinline__ int kperm(int pp) { return 8 * ((pp & 7) >> 2) + 4 * (pp >> 3) + (pp & 3); }

template <bool CACHE>
__device__ void item_prep(const Params& p, int l, int seq, int tile, char* smem) {
  const int tid = get_tid();
  u16* sV = (u16*)smem;
  const bool lat = seq >= 16;
  const int NK = lat ? 2560 : 256;
  const int L = lat ? 2048 : 256;
  const int tok0 = lat ? T_CTX + (seq - 16) * 2048 : seq * 256;
  const int s0 = tile * 64;
  const int key0 = CACHE ? 2048 + s0 : s0;
  const size_t base = kv_base(seq);
  (void)L;
  if (!CACHE) {
    for (int u = tid; u < 2048; u += 256) {
      const int rr = u >> 5, vid = (u >> 1) & 15, ax = u & 1;
      const int isk = vid >> 3, head = (vid >> 1) & 3, half = vid & 1;
      const int s = s0 + rr;
      const u16* src = p.proj + (size_t)(tok0 + s) * INW + (isk ? 2560 : 2048) + head * 128 + half * 64 + ax * 32;
      uint4 w[4];
#pragma unroll
      for (int i = 0; i < 4; i++) w[i] = *(const uint4*)(src + i * 8);
      uint32_t ww[16] = {w[0].x, w[0].y, w[0].z, w[0].w, w[1].x, w[1].y, w[1].z, w[1].w,
                         w[2].x, w[2].y, w[2].z, w[2].w, w[3].x, w[3].y, w[3].z, w[3].w};
      float x1[16], x2[16];
#pragma unroll
      for (int i = 0; i < 8; i++) {
        x1[2 * i] = lo2f(ww[i]); x1[2 * i + 1] = hi2f(ww[i]);
        x2[2 * i] = lo2f(ww[8 + i]); x2[2 * i + 1] = hi2f(ww[8 + i]);
      }
      const float scl = isk ? 1.f : 0.125f * 1.4426950408889634f;
      float o1[16], o2[16];
      if (lat) {
        const float* tab = ax == 0 ? p.rope + 2 * ((s >> 6) * 16) : p.rope + 2 * (512 + (s & 63) * 16);
#pragma unroll
        for (int i = 0; i < 16; i++) {
          const float cs = tab[2 * i], sn = tab[2 * i + 1];
          o1[i] = (x1[i] * cs - x2[i] * sn) * scl;
          o2[i] = (x1[i] * sn + x2[i] * cs) * scl;
        }
      } else {
#pragma unroll
        for (int i = 0; i < 16; i++) { o1[i] = x1[i] * scl; o2[i] = x2[i] * scl; }
      }
      u16* dst = isk ? p.Kb + base + ((size_t)(head * 2 + half) * NK + s) * 64 + ax * 32
                     : p.Qb + (size_t)(tok0 + s) * 512 + head * 128 + half * 64 + ax * 32;
      *(uint4*)(dst) = make_uint4(pack2(o1[0], o1[1]), pack2(o1[2], o1[3]), pack2(o1[4], o1[5]), pack2(o1[6], o1[7]));
      *(uint4*)(dst + 8) = make_uint4(pack2(o1[8], o1[9]), pack2(o1[10], o1[11]), pack2(o1[12], o1[13]), pack2(o1[14], o1[15]));
      *(uint4*)(dst + 16) = make_uint4(pack2(o2[0], o2[1]), pack2(o2[2], o2[3]), pack2(o2[4], o2[5]), pack2(o2[6], o2[7]));
      *(uint4*)(dst + 24) = make_uint4(pack2(o2[8], o2[9]), pack2(o2[10], o2[11]), pack2(o2[12], o2[13]), pack2(o2[14], o2[15]));
    }
  } else {
    const float* ck = p.in[2] + ((size_t)((seq - 16) * 2 + l) * 512 + s0) * 512;
    for (int u = tid; u < 4096; u += 256) {
      const int rr = u >> 6, head = (u >> 4) & 3, half = (u >> 3) & 1, c8 = u & 7;
      const float* src = ck + (size_t)rr * 512 + head * 128 + half * 64 + c8 * 8;
      float4 a = *(const float4*)src, b = *(const float4*)(src + 4);
      u16* dst = p.Kb + base + ((size_t)(head * 2 + half) * NK + key0 + rr) * 64 + c8 * 8;
      *(uint4*)dst = make_uint4(pack2(a.x, a.y), pack2(a.z, a.w), pack2(b.x, b.y), pack2(b.z, b.w));
    }
  }
  for (int head = 0; head < 4; head++) {
    __syncthreads();
    for (int u = tid; u < 1024; u += 256) {
      const int rr = u >> 4, c8 = u & 15;
      uint4 o;
      if (CACHE) {
        const float* src = p.in[3] + ((size_t)((seq - 16) * 2 + l) * 512 + s0 + rr) * 512 + head * 128 + c8 * 8;
        float4 a = *(const float4*)src, b = *(const float4*)(src + 4);
        o = make_uint4(pack2(a.x, a.y), pack2(a.z, a.w), pack2(b.x, b.y), pack2(b.z, b.w));
      } else {
        o = *(const uint4*)(p.proj + (size_t)(tok0 + s0 + rr) * INW + 3072 + head * 128 + c8 * 8);
      }
      *(uint4*)(sV + rr * 136 + c8 * 8) = o;
    }
    __syncthreads();
    {
      const int dv = tid >> 1, kb0 = (tid & 1) * 2;
#pragma unroll
      for (int kk = 0; kk < 2; kk++) {
        const int kb = kb0 + kk;
        uint32_t w[8];
#pragma unroll
        for (int pp = 0; pp < 8; pp++) {
          const u16 a = sV[(kb * 16 + kperm(2 * pp)) * 136 + dv];
          const u16 b = sV[(kb * 16 + kperm(2 * pp + 1)) * 136 + dv];
          w[pp] = (uint32_t)a | ((uint32_t)b << 16);
        }
        u16* dst = p.Vt + base + (size_t)head * 128 * NK + (size_t)((key0 + kb * 16) >> 5) * 4096 + dv * 32 + (kb & 1) * 16;
        *(uint4*)dst = make_uint4(w[0], w[1], w[2], w[3]);
        *(uint4*)(dst + 8) = make_uint4(w[4], w[5], w[6], w[7]);
      }
    }
  }
}

__device__ void ph_mixers(const Params& p, int l, char* smem) {
  for (int it0 = blockIdx.x; it0 < 768 + 608; it0 += gridDim.x) {
    const int it = it0 < 768 ? it0 : it0 - 768 + 320;
    if (it0 < 512) item_lru(p, l, 16 + (it0 >> 7), (it0 >> 4) & 7, (it0 >> 3) & 1, it0 & 7, smem);
    else if (it0 < 768) { int j = it0 - 512; item_lru(p, l, j >> 4, 0, (j >> 3) & 1, j & 7, smem); }
    else if (it < 704) { int j = it - 320; item_chunk_mlp(p, l, j >> 2, j & 3, smem); }
    else if (it < 896) {
      int j = it - 704;
      if (j < 64) item_prep<false>(p, l, j >> 2, j & 3, smem);
      else { j -= 64; item_prep<false>(p, l, 16 + (j >> 5), j & 31, smem); }
    } else { int j = it - 896; item_prep<true>(p, l, 16 + (j >> 3), j & 7, smem); }
  }
}

__device__ void item_attn(const Params& p, int l, int seq, int head, int qb, char* smem) {
  const int tid_ = get_tid(), lane = tid_ & 63, wave = tid_ >> 6;
  const int qs = wave >> 1, hf = wave & 1;
  float* sO = (float*)smem;
  const bool lat = seq >= 16;
  const int NK = lat ? 2560 : 256;
  const int tok0 = lat ? T_CTX + (seq - 16) * 2048 : seq * 256;
  const size_t base = kv_base(seq);
  const int q0 = qb * 64 + qs * 32;
  const int ql = lane & 31, hh = lane >> 5;
  bf16x8 qf[4];
#pragma unroll
  for (int ks = 0; ks < 4; ks++)
    qf[ks] = *(const bf16x8*)(p.Qb + (size_t)(tok0 + q0 + ql) * 512 + head * 128 + hf * 64 + ks * 16 + hh * 8);
  f32x16 O[4];
#pragma unroll
  for (int mt = 0; mt < 4; mt++)
#pragma unroll
    for (int r = 0; r < 16; r++) O[mt][r] = 0.f;
  float m_ = 0.f, l_ = 0.f;
  f32x16 negm;
#pragma unroll
  for (int r = 0; r < 16; r++) negm[r] = 0.f;
  constexpr int KST = 64 * 72, VST = 128 * 40, STG = KST + VST;
  u16* sKV = (u16*)smem;
  const int tid = wave * 64 + lane;
  const u16* Kg0 = p.Kb + base + (size_t)(head * 2) * NK * 64 + tid * 8;
  const u16* Kg1 = Kg0 + (size_t)NK * 64;
  const u16* Vg = p.Vt + base + (size_t)head * 128 * NK + tid * 8;
  u16* wk0 = sKV + ((tid >> 3) & 31) * 72 + (tid & 7) * 8;
  u16* wk1 = wk0 + 32 * 72;
  u16* wv0 = sKV + KST + (tid >> 2) * 40 + (tid & 3) * 8;
  u16* wv1 = wv0 + 64 * 40;
  const u16* rk = sKV + (hf * 32 + ql) * 72 + hh * 8;
  const u16* rv = sKV + KST + ql * 40 + hh * 8;
#define BC(x) __builtin_bit_cast(bf16x8, x)
#define LD4(p) (*(const u32x4*)(p))
  const int nkt = NK / 32;
  u32x4 gk0 = LD4(Kg0), gk1 = LD4(Kg1), gv0 = LD4(Vg), gv1 = LD4(Vg + 2048);
  __syncthreads();
  *(u32x4*)wk0 = gk0; *(u32x4*)wk1 = gk1; *(u32x4*)wv0 = gv0; *(u32x4*)wv1 = gv1;
  {
    const int k1 = nkt > 1 ? 1 : 0;
    gk0 = LD4(Kg0 + (size_t)k1 * 2048); gk1 = LD4(Kg1 + (size_t)k1 * 2048);
    gv0 = LD4(Vg + (size_t)k1 * 4096); gv1 = LD4(Vg + (size_t)k1 * 4096 + 2048);
  }
  for (int kt = 0; kt < nkt; kt++) {
    __syncthreads();
    const int cur = (kt & 1) * STG, nxt = STG - cur;
    if (kt + 1 < nkt) {
      *(u32x4*)(wk0 + nxt) = gk0; *(u32x4*)(wk1 + nxt) = gk1; *(u32x4*)(wv0 + nxt) = gv0; *(u32x4*)(wv1 + nxt) = gv1;
    }
    {
      const int k2 = (kt + 2 < nkt) ? kt + 2 : nkt - 1;
      gk0 = LD4(Kg0 + (size_t)k2 * 2048); gk1 = LD4(Kg1 + (size_t)k2 * 2048);
      gv0 = LD4(Vg + (size_t)k2 * 4096); gv1 = LD4(Vg + (size_t)k2 * 4096 + 2048);
    }
    __builtin_amdgcn_sched_barrier(0);
    const bf16x8 kc0 = *(const bf16x8*)(rk + cur), kc1 = *(const bf16x8*)(rk + cur + 16), kc2 = *(const bf16x8*)(rk + cur + 32),
                 kc3 = *(const bf16x8*)(rk + cur + 48);
    const bf16x8 v0 = *(const bf16x8*)(rv + cur), v1 = *(const bf16x8*)(rv + cur + 16);
    const bf16x8 v2 = *(const bf16x8*)(rv + cur + 32 * 40), v3 = *(const bf16x8*)(rv + cur + 32 * 40 + 16);
    const bf16x8 v4 = *(const bf16x8*)(rv + cur + 64 * 40), v5 = *(const bf16x8*)(rv + cur + 64 * 40 + 16);
    const bf16x8 v6 = *(const bf16x8*)(rv + cur + 96 * 40), v7 = *(const bf16x8*)(rv + cur + 96 * 40 + 16);
    f32x16 s = __builtin_amdgcn_mfma_f32_32x32x16_bf16(kc0, qf[0], negm, 0, 0, 0);
    s = __builtin_amdgcn_mfma_f32_32x32x16_bf16(kc1, qf[1], s, 0, 0, 0);
    s = __builtin_amdgcn_mfma_f32_32x32x16_bf16(kc2, qf[2], s, 0, 0, 0);
    s = __builtin_amdgcn_mfma_f32_32x32x16_bf16(kc3, qf[3], s, 0, 0, 0);
    float mx = fmaxf(s[0], s[1]);
#pragma unroll
    for (int r = 2; r < 16; r += 2) mx = fmaxf(mx, fmaxf(s[r], s[r + 1]));
    mx = fmaxf(mx, __shfl_xor(mx, 32));
    if (kt == 0 || __builtin_amdgcn_ballot_w64(mx > 8.f) != 0ull) {
      const float d = kt == 0 ? mx : fmaxf(mx, 0.f);
      const float alpha = kt == 0 ? 1.f : __builtin_amdgcn_exp2f(-d);
      l_ *= alpha;
      m_ += d;
#pragma unroll
      for (int r = 0; r < 16; r++) { s[r] -= d; negm[r] = -m_; }
#pragma unroll
      for (int mt = 0; mt < 4; mt++)
#pragma unroll
        for (int r = 0; r < 16; r++) O[mt][r] *= alpha;
    }
    float rs = 0.f;
#pragma unroll
    for (int r = 0; r < 16; r++) { s[r] = __builtin_amdgcn_exp2f(s[r]); rs += s[r]; }
    rs += __shfl_xor(rs, 32);
    l_ += rs;
    bf16x8 pf0, pf1;
    {
      typedef uint32_t u32x4_ __attribute__((ext_vector_type(4)));
      u32x4_ w0, w1;
      w0[0] = pack2(s[0], s[1]); w0[1] = pack2(s[2], s[3]); w0[2] = pack2(s[4], s[5]); w0[3] = pack2(s[6], s[7]);
      w1[0] = pack2(s[8], s[9]); w1[1] = pack2(s[10], s[11]); w1[2] = pack2(s[12], s[13]); w1[3] = pack2(s[14], s[15]);
      pf0 = __builtin_bit_cast(bf16x8, w0);
      pf1 = __builtin_bit_cast(bf16x8, w1);
    }
    O[0] = __builtin_amdgcn_mfma_f32_32x32x16_bf16(v0, pf0, O[0], 0, 0, 0);
    O[0] = __builtin_amdgcn_mfma_f32_32x32x16_bf16(v1, pf1, O[0], 0, 0, 0);
    O[1] = __builtin_amdgcn_mfma_f32_32x32x16_bf16(v2, pf0, O[1], 0, 0, 0);
    O[1] = __builtin_amdgcn_mfma_f32_32x32x16_bf16(v3, pf1, O[1], 0, 0, 0);
    O[2] = __builtin_amdgcn_mfma_f32_32x32x16_bf16(v4, pf0, O[2], 0, 0, 0);
    O[2] = __builtin_amdgcn_mfma_f32_32x32x16_bf16(v5, pf1, O[2], 0, 0, 0);
    O[3] = __builtin_amdgcn_mfma_f32_32x32x16_bf16(v6, pf0, O[3], 0, 0, 0);
    O[3] = __builtin_amdgcn_mfma_f32_32x32x16_bf16(v7, pf1, O[3], 0, 0, 0);
    __builtin_amdgcn_sched_barrier(0);
  }
  const float lam = p.lam[l];
  const float sc = hf == 0 ? 1.f / l_ : lam / l_;
  __syncthreads();
  if (hf == 1) {
#pragma unroll
    for (int mt = 0; mt < 4; mt++)
#pragma unroll
      for (int r = 0; r < 16; r++) sO[(qs * 64 + mt * 16 + r) * 64 + lane] = O[mt][r] * sc;
  }
  __syncthreads();
  if (hf == 0) {
    float ss = 0.f;
#pragma unroll
    for (int mt = 0; mt < 4; mt++)
#pragma unroll
      for (int r = 0; r < 16; r++) {
        const float o = O[mt][r] * sc - sO[(qs * 64 + mt * 16 + r) * 64 + lane];
        O[mt][r] = o;
        ss += o * o;
      }
    ss += __shfl_xor(ss, 32);
    const float rstd = rsqrtf(ss * (1.f / 128.f) + 1e-6f) * (1.f - lam_init_of(l));
    const float* sub = p.in[23] + l * 128;
    const int tq = tok0 + q0 + ql;
#pragma unroll
    for (int mt = 0; mt < 4; mt++)
#pragma unroll
      for (int g = 0; g < 4; g++) {
        const int dv = mt * 32 + 8 * g + 4 * hh;
        const float4 sb = *(const float4*)(sub + dv);
        uint2 o;
        o.x = pack2(O[mt][4 * g] * rstd * sb.x, O[mt][4 * g + 1] * rstd * sb.y);
        o.y = pack2(O[mt][4 * g + 2] * rstd * sb.z, O[mt][4 * g + 3] * rstd * sb.w);
        *(uint2*)(p.yc + blk_off(tq, head * 128 + dv)) = o;
      }
  }
}

__device__ void ph_attn(const Params& p, int l, char* smem) {
  for (int it = blockIdx.x; it < 768 + 384; it += gridDim.x) {
    if (it < 512) item_attn(p, l, 16 + (it >> 7), (it >> 5) & 3, it & 31, smem);
    else if (it < 768) { int j = it - 512; item_attn(p, l, j >> 4, (j >> 2) & 3, j & 3, smem); }
    else {
      const int tid = get_tid();
      const int c = (tid & 63) * 8, tl = tid >> 6;
      const int t0 = (it - 768) * 32;
      float hinf[8], hinb[8];
#pragma unroll
      for (int j = 0; j < 8; j++) { hinf[j] = 0.f; hinb[j] = 0.f; }
      const bool latc = t0 >= T_CTX;
      if (latc) {
        const int sq = (t0 - T_CTX) >> 11, spos = (t0 - T_CTX) & 2047;
#pragma unroll
        for (int d = 0; d < 2; d++) {
          const int sg = (d == 0 ? spos : 2047 - spos) >> 8;
          float hin[8];
          const float* h0 = p.in[4] + ((sq * 2 + l) * 2 + d) * 512 + c;
#pragma unroll
          for (int j = 0; j < 8; j++) hin[j] = h0[j];
          const float* st = p.segtot + (((size_t)sq * 2 + d) * 8) * 2 * 512 + c;
          for (int j2 = 0; j2 < sg; j2++) {
            const float4 a0 = *(const float4*)(st + j2 * 1024), a1 = *(const float4*)(st + j2 * 1024 + 4);
            const float4 b0 = *(const float4*)(st + j2 * 1024 + 512), b1 = *(const float4*)(st + j2 * 1024 + 516);
            hin[0] = a0.x * hin[0] + b0.x; hin[1] = a0.y * hin[1] + b0.y; hin[2] = a0.z * hin[2] + b0.z; hin[3] = a0.w * hin[3] + b0.w;
            hin[4] = a1.x * hin[4] + b1.x; hin[5] = a1.y * hin[5] + b1.y; hin[6] = a1.z * hin[6] + b1.z; hin[7] = a1.w * hin[7] + b1.w;
          }
#pragma unroll
          for (int j = 0; j < 8; j++) { if (d == 0) hinf[j] = hin[j]; else hinb[j] = hin[j]; }
        }
      }
#pragma unroll 2
      for (int i = 0; i < 8; i++) {
        const int t = t0 + tl + 4 * i;
        const size_t o = (size_t)t * 512 + c;
        const uint4 f = *(const uint4*)(p.hs + o), b = *(const uint4*)(p.hs + (size_t)T_ALL * 512 + o);
        const uint4 g = *(const uint4*)(p.proj + (size_t)t * INW + 1536 + c);
        float hv[8];
        hv[0] = lo2f(f.x) + lo2f(b.x); hv[1] = hi2f(f.x) + hi2f(b.x); hv[2] = lo2f(f.y) + lo2f(b.y); hv[3] = hi2f(f.y) + hi2f(b.y);
        hv[4] = lo2f(f.z) + lo2f(b.z); hv[5] = hi2f(f.z) + hi2f(b.z); hv[6] = lo2f(f.w) + lo2f(b.w); hv[7] = hi2f(f.w) + hi2f(b.w);
        if (latc) {
          const uint4 af = *(const uint4*)(p.acum + o), ab = *(const uint4*)(p.acum + (size_t)T_ALL * 512 + o);
          hv[0] += lo2f(af.x) * hinf[0] + lo2f(ab.x) * hinb[0]; hv[1] += hi2f(af.x) * hinf[1] + hi2f(ab.x) * hinb[1];
          hv[2] += lo2f(af.y) * hinf[2] + lo2f(ab.y) * hinb[2]; hv[3] += hi2f(af.y) * hinf[3] + hi2f(ab.y) * hinb[3];
          hv[4] += lo2f(af.z) * hinf[4] + lo2f(ab.z) * hinb[4]; hv[5] += hi2f(af.z) * hinf[5] + hi2f(ab.z) * hinb[5];
          hv[6] += lo2f(af.w) * hinf[6] + lo2f(ab.w) * hinb[6]; hv[7] += hi2f(af.w) * hinf[7] + hi2f(ab.w) * hinb[7];
        }
        uint4 oo;
        oo.x = pack2(hv[0] * gelu_tanh(lo2f(g.x)), hv[1] * gelu_tanh(hi2f(g.x)));
        oo.y = pack2(hv[2] * gelu_tanh(lo2f(g.y)), hv[3] * gelu_tanh(hi2f(g.y)));
        oo.z = pack2(hv[4] * gelu_tanh(lo2f(g.z)), hv[5] * gelu_tanh(hi2f(g.z)));
        oo.w = pack2(hv[6] * gelu_tanh(lo2f(g.w)), hv[7] * gelu_tanh(hi2f(g.w)));
        *(uint4*)(p.yb + blk_off(t, c)) = oo;
      }
    }
  }
}

__device__ void ph_merge(const Params& p, int l, char* smem, const Blk& bk) {
  u16* sA = (u16*)smem; u16* sB = sA + 2 * 128 * LDS_STRIDE;
  const int tid_ = get_tid(), lane = tid_ & 63, wave = tid_ >> 6, wm = wave >> 1, wn = wave & 1;
  const int xcd = bk.xcd;
  for (int lt = bk.rank; lt < 12 * 16; lt += bk.nblk) {
    const int mt = xcd * 12 + lt % 12, nt = lt / 12;
    const int n = nt * 64 + wn * 32 + (lane & 31);
    f32x16 mg[2][1];
#pragma unroll
    for (int i = 0; i < 2; i++)
#pragma unroll
      for (int r = 0; r < 16; r++) mg[i][0][r] = 0.f;
#pragma unroll 1
    for (int br = 0; br < 3; br++) {
      const u16* A = (br == 0 ? p.ya : br == 1 ? p.yb : p.yc) + (size_t)mt * 128 * 64;
      const u16* W = (br == 0 ? p.WtUpA : br == 1 ? p.WtUpB : p.WtUpC) + (size_t)l * 524288 + (size_t)nt * 64 * 64;
      f32x16 acc[2][1];
#pragma unroll
      for (int i = 0; i < 2; i++)
#pragma unroll
        for (int r = 0; r < 16; r++) acc[i][0][r] = 0.f;
      gemm_core<1>(A, (size_t)T_ALL * 64, W, (size_t)1024 * 64, 512, acc, sA, sB);
      __syncthreads();
      {
        const int tid = get_tid();
#pragma unroll
        for (int q = 0; q < 4; q++) {
          const int row = (tid >> 3) + 32 * q, c8 = (tid & 7) * 8;
          *(uint4*)(sA + row * LDS_STRIDE + c8) =
              *(const uint4*)(p.proj + (size_t)(mt * 128 + row) * INW + 3584 + br * 1024 + nt * 64 + c8);
        }
      }
      __syncthreads();
#pragma unroll
      for (int i = 0; i < 2; i++)
#pragma unroll
        for (int r = 0; r < 16; r++) {
          const int row = ACC_ROW(wm, i, r, lane);
          const float g = sigmoidf_(bf2f(sA[row * LDS_STRIDE + wn * 32 + (lane & 31)]));
          mg[i][0][r] += g * acc[i][0][r];
        }
    }
    __syncthreads();
    stage_tile_bf16<1>(mg, sA, wm, wn, lane);
    __syncthreads();
    {
      const int tid = wave * 64 + lane;
      u16* dst = p.h + blk_off(mt * 128, nt * 64);
#pragma unroll
      for (int q = 0; q < 4; q++) {
        const int idx = tid + 256 * q, row = idx >> 3, ch = idx & 7;
        *(uint4*)(dst + row * 64 + ch * 8) = *(const uint4*)(sA + row * 72 + ch * 8);
      }
    }
  }
}

__device__ void ph_out(const Params& p, int l, char* smem, const Blk& bk) {
  u16* sA = (u16*)smem; u16* sB = sA + 2 * 128 * LDS_STRIDE;
  const int tid_ = get_tid(), lane = tid_ & 63, wave = tid_ >> 6, wm = wave >> 1, wn = wave & 1;
  const int xcd = bk.xcd;
  for (int lt = bk.rank; lt < 12 * 16; lt += bk.nblk) {
    const int mt = xcd * 12 + lt % 12, nt = lt / 12;
    f32x16 acc[2][1];
#pragma unroll
    for (int i = 0; i < 2; i++)
#pragma unroll
      for (int r = 0; r < 16; r++) acc[i][0][r] = 0.f;
    gemm_core<1>(p.h + (size_t)mt * 128 * 64, (size_t)T_ALL * 64, p.WtOut + (size_t)l * 1048576 + (size_t)nt * 64 * 64, (size_t)1024 * 64, DM, acc, sA, sB);
    __syncthreads();
    float* sF = (float*)smem;
#pragma unroll
    for (int i = 0; i < 2; i++)
#pragma unroll
      for (int r = 0; r < 16; r++) sF[ACC_ROW(wm, i, r, lane) * 68 + wn * 32 + (lane & 31)] = acc[i][0][r];
    __syncthreads();
    {
      const int tid = wave * 64 + lane;
      const float* gm = p.mod + ((size_t)l * 5 + cond_of(mt * 128)) * 6144 + 2048 + nt * 64;
#pragma unroll
      for (int q = 0; q < 8; q++) {
        const int idx = tid + 256 * q, row = idx >> 4, c4 = (idx & 15) * 4;
        const int t = mt * 128 + row;
        const float* xr = (l == 0 ? in_xrow(p.in[0], p.in[1], t) : p.x + (size_t)t * DM) + nt * 64 + c4;
        const float4 xv = *(const float4*)xr, g = *(const float4*)(gm + c4), a = *(const float4*)(sF + row * 68 + c4);
        *(float4*)(p.xmid + (size_t)t * DM + nt * 64 + c4) = make_float4(xv.x + g.x * a.x, xv.y + g.y * a.y, xv.z + g.z * a.z, xv.w + g.w * a.w);
      }
    }
  }
}

__device__ void ph_peer_q(const Params& p, int l, char* smem, const Blk& bk) {
  u16* sA = (u16*)smem; u16* sB = sA + 2 * 128 * LDS_STRIDE;
  const int tid_ = get_tid(), lane = tid_ & 63, wave = tid_ >> 6, wm = wave >> 1, wn = wave & 1;
  u16* pq = p.proj;
  const int xcd = bk.xcd;
  for (int lt = bk.rank; lt < 12 * 16; lt += bk.nblk) {
    const int mt = xcd * 12 + lt % 12, nt = lt / 12;
    f32x16 acc[2][2];
    ACC_ZERO(acc);
    gemm_core<2>(p.h + (size_t)mt * 128 * 64, (size_t)T_ALL * 64, p.WtQ + (size_t)l * 2097152 + (size_t)nt * 128 * 64, (size_t)2048 * 64, DM, acc, sA, sB);
    __syncthreads();
    stage_tile_bf16<2>(acc, sA, wm, wn, lane);
    __syncthreads();
    {
      const int tid = wave * 64 + lane;
#pragma unroll
      for (int q = 0; q < 8; q++) {
        const int idx = tid + 256 * q, row = idx >> 4, ch = idx & 15;
        *(uint4*)(pq + (size_t)(mt * 128 + row) * 2048 + nt * 128 + ch * 8) = *(const uint4*)(sA + row * 136 + ch * 8);
      }
    }
  }
}

__device__ __forceinline__ void ins16(float (&lst)[16], float v) {
#pragma unroll
  for (int j = 0; j < 16; j++) {
    const float hi = fmaxf(lst[j], v);
    v = fminf(lst[j], v);
    lst[j] = hi;
  }
}
template <int CTRL>
__device__ __forceinline__ float dppf(float v) {
  return __uint_as_float((uint32_t)__builtin_amdgcn_update_dpp(0, (int)__float_as_uint(v), CTRL, 0xf, 0xf, true));
}
template <int CTRL>
__device__ __forceinline__ void merge16(float (&lst)[16]) {
  float o[16];
#pragma unroll
  for (int j = 0; j < 16; j++) o[j] = dppf<CTRL>(lst[j]);
#pragma unroll
  for (int j = 0; j < 16; j++) lst[j] = fmaxf(lst[j], o[15 - j]);
#define BSTAGE(ST)                                                                    \
  _Pragma("unroll") for (int i = 0; i < 16; i++)                                       \
    if ((i & ST) == 0) {                                                               \
      const float hi = fmaxf(lst[i], lst[i + ST]), lo = fminf(lst[i], lst[i + ST]);    \
      lst[i] = hi; lst[i + ST] = lo;                                                   \
    }
  BSTAGE(8) BSTAGE(4) BSTAGE(2) BSTAGE(1)
#undef BSTAGE
}
__device__ void ph_route(const Params& p, int l, char* smem) {
  const int tid = get_tid(), lane = tid & 63, wave = tid >> 6;
  float* sS = (float*)smem;
  uint32_t* sTop = (uint32_t*)(sS + 2 * 64 * 129);
  const u16* pq = p.proj;
  for (int it = blockIdx.x; it < 192 * 8; it += gridDim.x) {
    const int tt = it >> 3, head = it & 7;
    const int t0 = tt * 64;
    __syncthreads();
    {
      const int half = wave & 1, kh = wave >> 1;
      const u16* A = pq + (size_t)t0 * 2048 + head * 256 + half * 128;
      const u16* B = p.KeysB + (size_t)l * 32768 + half * 16384 + (size_t)kh * 64 * 128;
      f32x16 acc[2][2];
      ACC_ZERO(acc);
#pragma unroll
      for (int ks = 0; ks < 8; ks++) {
        bf16x8 a[2], b[2];
#pragma unroll
        for (int i = 0; i < 2; i++) {
          a[i] = *(const bf16x8*)(A + (size_t)(i * 32 + (lane & 31)) * 2048 + ks * 16 + (lane >> 5) * 8);
          b[i] = *(const bf16x8*)(B + (i * 32 + (lane & 31)) * 128 + ks * 16 + (lane >> 5) * 8);
        }
#pragma unroll
        for (int i = 0; i < 2; i++)
#pragma unroll
          for (int j = 0; j < 2; j++) acc[i][j] = __builtin_amdgcn_mfma_f32_32x32x16_bf16(a[i], b[j], acc[i][j], 0, 0, 0);
      }
#pragma unroll
      for (int i = 0; i < 2; i++)
#pragma unroll
        for (int j = 0; j < 2; j++) {
          const int key = kh * 64 + j * 32 + (lane & 31);
#pragma unroll
          for (int r = 0; r < 16; r++) {
            const int tk = i * 32 + (r & 3) + 8 * (r >> 2) + 4 * (lane >> 5);
            sS[(half * 64 + tk) * 129 + key] = acc[i][j][r];
          }
        }
    }
    __syncthreads();
    {
      const int tokl = lane >> 2, sub = lane & 3, half = sub >> 1, part = sub & 1;
      const int tok = wave * 16 + tokl;
      const float* row = sS + (half * 64 + tok) * 129 + part * 64;
      float lst[16];
#pragma unroll
      for (int j = 0; j < 16; j++) lst[j] = -3.0e38f;
#pragma unroll 4
      for (int k = 0; k < 64; k++) {
        const float v = __uint_as_float((__float_as_uint(row[k]) & 0xffffff80u) | (uint32_t)(part * 64 + k));
        ins16(lst, v);
      }
      merge16<0xB1>(lst);
      float a[16], b[16];
#pragma unroll
      for (int j = 0; j < 16; j++) {
        const float o = dppf<0x4E>(lst[j]);
        a[j] = half ? o : lst[j];
        b[j] = half ? lst[j] : o;
      }
      float cl[16];
#pragma unroll
      for (int j = 0; j < 16; j++) cl[j] = -3.0e38f;
      {
        float val = -3.0e38f;
        int c = 0;
#pragma unroll
        for (int i = 0; i < 16; i++)
#pragma unroll
          for (int j = 0; j < 16; j++)
            if ((i + 1) * (j + 1) <= 16) {
              const float sm = __uint_as_float(__float_as_uint(a[i]) & 0xffffff80u) + __uint_as_float(__float_as_uint(b[j]) & 0xffffff80u);
              const float pv = __uint_as_float((__float_as_uint(sm) & 0xffffff00u) | (uint32_t)(i * 16 + j));
              val = ((c & 3) == sub) ? pv : val;
              if ((c & 3) == 3) { ins16(cl, val); val = -3.0e38f; }
              c++;
            }
        ins16(cl, val);
      }
      merge16<0xB1>(cl);
      merge16<0x4E>(cl);
      float mx = -3.0e38f;
#pragma unroll
      for (int j = 0; j < 16; j++) mx = fmaxf(mx, __uint_as_float(__float_as_uint(cl[j]) & 0xffffff00u));
      float sum = 0.f;
#pragma unroll
      for (int j = 0; j < 16; j++) sum += __expf(__uint_as_float(__float_as_uint(cl[j]) & 0xffffff00u) - mx);
      const float inv = __builtin_amdgcn_rcpf(sum);
      int* ip = p.pidx + (size_t)(t0 + tok) * 128 + head * 16 + sub * 4;
      float* gp = p.pgate + (size_t)(t0 + tok) * 128 + head * 16 + sub * 4;
      const uint32_t sm0 = sub == 0 ? 0xffffffffu : 0u, sm1 = sub == 1 ? 0xffffffffu : 0u, sm2 = sub == 2 ? 0xffffffffu : 0u,
                     sm3 = sub == 3 ? 0xffffffffu : 0u;
#pragma unroll
      for (int jj = 0; jj < 4; jj++) {
        const float ent = __uint_as_float((__float_as_uint(cl[jj]) & sm0) | (__float_as_uint(cl[4 + jj]) & sm1) |
                                          (__float_as_uint(cl[8 + jj]) & sm2) | (__float_as_uint(cl[12 + jj]) & sm3));
        const uint32_t code = __float_as_uint(ent) & 0xffu;
        const int ci = code >> 4, cj = code & 15;
        uint32_t ai = 0, bj = 0;
#pragma unroll
        for (int q = 0; q < 16; q++) { ai = (ci == q) ? __float_as_uint(a[q]) : ai; bj = (cj == q) ? __float_as_uint(b[q]) : bj; }
        ip[jj] = (int)((ai & 127u) * 128u + (bj & 127u));
        gp[jj] = __expf(__uint_as_float(__float_as_uint(ent) & 0xffffff00u) - mx) * inv;
      }
    }
  }
}

__device__ __forceinline__ float dot16_fp8(const uint4& w, const float (&hx)[16]) {
  float s = 0.f;
  f32x2 a;
  a = __builtin_amdgcn_cvt_pk_f32_fp8((int)w.x, false); s += a.x * hx[0] + a.y * hx[1];
  a = __builtin_amdgcn_cvt_pk_f32_fp8((int)w.x, true);  s += a.x * hx[2] + a.y * hx[3];
  a = __builtin_amdgcn_cvt_pk_f32_fp8((int)w.y, false); s += a.x * hx[4] + a.y * hx[5];
  a = __builtin_amdgcn_cvt_pk_f32_fp8((int)w.y, true);  s += a.x * hx[6] + a.y * hx[7];
  a = __builtin_amdgcn_cvt_pk_f32_fp8((int)w.z, false); s += a.x * hx[8] + a.y * hx[9];
  a = __builtin_amdgcn_cvt_pk_f32_fp8((int)w.z, true);  s += a.x * hx[10] + a.y * hx[11];
  a = __builtin_amdgcn_cvt_pk_f32_fp8((int)w.w, false); s += a.x * hx[12] + a.y * hx[13];
  a = __builtin_amdgcn_cvt_pk_f32_fp8((int)w.w, true);  s += a.x * hx[14] + a.y * hx[15];
  return s;
}
__device__ __forceinline__ float dot16_fp4(const uint2& w, const f32x2 (&hx2)[8]) {
  f32x2 s = __builtin_amdgcn_cvt_scalef32_pk_f32_fp4(w.x, 1.0f, 0) * hx2[0];
  s += __builtin_amdgcn_cvt_scalef32_pk_f32_fp4(w.x, 1.0f, 1) * hx2[1];
  s += __builtin_amdgcn_cvt_scalef32_pk_f32_fp4(w.x, 1.0f, 2) * hx2[2];
  s += __builtin_amdgcn_cvt_scalef32_pk_f32_fp4(w.x, 1.0f, 3) * hx2[3];
  s += __builtin_amdgcn_cvt_scalef32_pk_f32_fp4(w.y, 1.0f, 0) * hx2[4];
  s += __builtin_amdgcn_cvt_scalef32_pk_f32_fp4(w.y, 1.0f, 1) * hx2[5];
  s += __builtin_amdgcn_cvt_scalef32_pk_f32_fp4(w.y, 1.0f, 2) * hx2[6];
  s += __builtin_amdgcn_cvt_scalef32_pk_f32_fp4(w.y, 1.0f, 3) * hx2[7];
  return s.x + s.y;
}
__device__ __forceinline__ void axpy16_fp4(const uint2& w, float c, f32x2 (&acc2)[8]) {
  const f32x2 c2 = {c, c};
  acc2[0] += c2 * __builtin_amdgcn_cvt_scalef32_pk_f32_fp4(w.x, 1.0f, 0);
  acc2[1] += c2 * __builtin_amdgcn_cvt_scalef32_pk_f32_fp4(w.x, 1.0f, 1);
  acc2[2] += c2 * __builtin_amdgcn_cvt_scalef32_pk_f32_fp4(w.x, 1.0f, 2);
  acc2[3] += c2 * __builtin_amdgcn_cvt_scalef32_pk_f32_fp4(w.x, 1.0f, 3);
  acc2[4] += c2 * __builtin_amdgcn_cvt_scalef32_pk_f32_fp4(w.y, 1.0f, 0);
  acc2[5] += c2 * __builtin_amdgcn_cvt_scalef32_pk_f32_fp4(w.y, 1.0f, 1);
  acc2[6] += c2 * __builtin_amdgcn_cvt_scalef32_pk_f32_fp4(w.y, 1.0f, 2);
  acc2[7] += c2 * __builtin_amdgcn_cvt_scalef32_pk_f32_fp4(w.y, 1.0f, 3);
}
__device__ __forceinline__ void axpy16_fp8(const uint4& w, float c, float (&acc)[16]) {
  f32x2 a;
  a = __builtin_amdgcn_cvt_pk_f32_fp8((int)w.x, false); acc[0] += c * a.x; acc[1] += c * a.y;
  a = __builtin_amdgcn_cvt_pk_f32_fp8((int)w.x, true);  acc[2] += c * a.x; acc[3] += c * a.y;
  a = __builtin_amdgcn_cvt_pk_f32_fp8((int)w.y, false); acc[4] += c * a.x; acc[5] += c * a.y;
  a = __builtin_amdgcn_cvt_pk_f32_fp8((int)w.y, true);  acc[6] += c * a.x; acc[7] += c * a.y;
  a = __builtin_amdgcn_cvt_pk_f32_fp8((int)w.z, false); acc[8] += c * a.x; acc[9] += c * a.y;
  a = __builtin_amdgcn_cvt_pk_f32_fp8((int)w.z, true);  acc[10] += c * a.x; acc[11] += c * a.y;
  a = __builtin_amdgcn_cvt_pk_f32_fp8((int)w.w, false); acc[12] += c * a.x; acc[13] += c * a.y;
  a = __builtin_amdgcn_cvt_pk_f32_fp8((int)w.w, true);  acc[14] += c * a.x; acc[15] += c * a.y;
}
__device__ __forceinline__ float reduce16(const float (&part)[16], int b5, int b4, int b3, int b2) {
  float p8[8], p4[4], p2[2], p1;
#pragma unroll
  for (int i = 0; i < 8; i++) {
    const float keep = b5 ? part[8 + i] : part[i], send = b5 ? part[i] : part[8 + i];
    p8[i] = keep + __shfl_xor(send, 32);
  }
#pragma unroll
  for (int i = 0; i < 4; i++) {
    const float keep = b4 ? p8[4 + i] : p8[i], send = b4 ? p8[i] : p8[4 + i];
    p4[i] = keep + __shfl_xor(send, 16);
  }
#pragma unroll
  for (int i = 0; i < 2; i++) {
    const float keep = b3 ? p4[2 + i] : p4[i], send = b3 ? p4[i] : p4[2 + i];
    p2[i] = keep + __shfl_xor(send, 8);
  }
  {
    const float keep = b2 ? p2[1] : p2[0], send = b2 ? p2[0] : p2[1];
    p1 = keep + __shfl_xor(send, 4);
  }
  p1 += __shfl_xor(p1, 2);
  p1 += __shfl_xor(p1, 1);
  return p1;
}
__device__ void ph_gather(const Params& p, int l, char* smem) {
  const int tid_ = get_tid(), lane = tid_ & 63, wave = tid_ >> 6;
  const unsigned char* PU = (const unsigned char*)p.PU + (size_t)l * 16384 * PU_ROWB;
  const unsigned char* PV = (const unsigned char*)p.PV + (size_t)l * 16384 * PV_ROWB;
  const int b5 = (lane >> 5) & 1, b4 = (lane >> 4) & 1, b3 = (lane >> 3) & 1, b2 = (lane >> 2) & 1;
  for (int t = blockIdx.x * 4 + wave; t < T_ALL; t += gridDim.x * 4) {
    float hx[16];
    {
      const u16* hr = p.h + blk_off(t, lane * 16);
      uint4 w0 = *(const uint4*)(hr), w1 = *(const uint4*)(hr + 8);
      hx[0] = lo2f(w0.x); hx[1] = hi2f(w0.x); hx[2] = lo2f(w0.y); hx[3] = hi2f(w0.y);
      hx[4] = lo2f(w0.z); hx[5] = hi2f(w0.z); hx[6] = lo2f(w0.w); hx[7] = hi2f(w0.w);
      hx[8] = lo2f(w1.x); hx[9] = hi2f(w1.x); hx[10] = lo2f(w1.y); hx[11] = hi2f(w1.y);
      hx[12] = lo2f(w1.z); hx[13] = hi2f(w1.z); hx[14] = lo2f(w1.w); hx[15] = hi2f(w1.w);
    }
    float acc[16];
#pragma unroll
    for (int j = 0; j < 16; j++) acc[j] = 0.f;
    f32x2 hx2[8], acc2[8];
#pragma unroll
    for (int j = 0; j < 8; j++) { hx2[j][0] = hx[2 * j]; hx2[j][1] = hx[2 * j + 1]; acc2[j][0] = 0.f; acc2[j][1] = 0.f; }
    const int me = (lane >> 2) & 15;
    float* sW = (float*)smem + wave * 512;
    if (U_FP4) {
#pragma unroll 1
      for (int head = 0; head < 8; head += 2) {
        const int myidx = p.pidx[(size_t)t * 128 + head * 16 + (lane & 31)];
        float pa[16], pb[16];
        {
          uint2 w[32];
#pragma unroll
          for (int e = 0; e < 32; e++) {
            const int idx = __builtin_amdgcn_readlane(myidx, e);
            w[e] = *(const uint2*)(PU + (size_t)idx * 512 + lane * 8);
          }
          __builtin_amdgcn_sched_barrier(0);
#pragma unroll
          for (int e = 0; e < 16; e++) { pa[e] = dot16_fp4(w[e], hx2); pb[e] = dot16_fp4(w[16 + e], hx2); }
          __builtin_amdgcn_sched_barrier(0);
        }
        const float ra = reduce16(pa, b5, b4, b3, b2), rb = reduce16(pb, b5, b4, b3, b2);
        sW[head * 64 + lane] = p.pgate[(size_t)t * 128 + head * 16 + me] * gelu_tanh(ra * (1.f / PU_SCALE)) * (1.f / PV_SCALE);
        sW[(head + 1) * 64 + lane] = p.pgate[(size_t)t * 128 + (head + 1) * 16 + me] * gelu_tanh(rb * (1.f / PU_SCALE)) * (1.f / PV_SCALE);
        __builtin_amdgcn_sched_barrier(0);
      }
    } else {
#pragma unroll 1
      for (int head = 0; head < 8; head++) {
        const int myidx = p.pidx[(size_t)t * 128 + head * 16 + (lane & 15)];
        float part[16];
#pragma unroll
        for (int eg = 0; eg < 2; eg++) {
          uint4 w[8];
#pragma unroll
          for (int e = 0; e < 8; e++) {
            const int idx = __builtin_amdgcn_readlane(myidx, eg * 8 + e);
            w[e] = *(const uint4*)(PU + (size_t)idx * 1024 + lane * 16);
          }
#pragma unroll
          for (int e = 0; e < 8; e++) part[eg * 8 + e] = dot16_fp8(w[e], hx);
          __builtin_amdgcn_sched_barrier(0);
        }
        const float p1 = reduce16(part, b5, b4, b3, b2);
        sW[head * 64 + lane] = p.pgate[(size_t)t * 128 + head * 16 + me] * gelu_tanh(p1 * (1.f / PU_SCALE)) * (1.f / PV_SCALE);
        __builtin_amdgcn_sched_barrier(0);
      }
    }
#pragma unroll 1
    for (int head = 0; head < 8; head += (V_FP4 ? 2 : 1)) {
      const int myidx = p.pidx[(size_t)t * 128 + head * 16 + (lane & 31)];
      const float wgh = sW[head * 64 + lane];
      if (V_FP4) {
        const float wgh1 = sW[(head + 1) * 64 + lane];
        uint2 w[32];
#pragma unroll
        for (int e = 0; e < 32; e++) {
          const int idx = __builtin_amdgcn_readlane(myidx, e);
          w[e] = *(const uint2*)(PV + (size_t)idx * 512 + lane * 8);
        }
        __builtin_amdgcn_sched_barrier(0);
#pragma unroll
        for (int e = 0; e < 32; e++) {
          const float c = __uint_as_float(__builtin_amdgcn_readlane(__float_as_uint(e < 16 ? wgh : wgh1), 4 * (e & 15)));
          axpy16_fp4(w[e], c, acc2);
        }
      } else {
        uint4 w[16];
#pragma unroll
        for (int e = 0; e < 16; e++) {
          const int idx = __builtin_amdgcn_readlane(myidx, e);
          w[e] = *(const uint4*)(PV + (size_t)idx * 1024 + lane * 16);
        }
        __builtin_amdgcn_sched_barrier(0);
#pragma unroll
        for (int e = 0; e < 16; e++) {
          const float c = __uint_as_float(__builtin_amdgcn_readlane(__float_as_uint(wgh), 4 * e));
          axpy16_fp8(w[e], c, acc);
        }
      }
      __builtin_amdgcn_sched_barrier(0);
    }
    if (V_FP4) {
#pragma unroll
      for (int j = 0; j < 8; j++) { acc[2 * j] = acc2[j][0]; acc[2 * j + 1] = acc2[j][1]; }
    }
    float xv[16];
    load_row16<true>(p.xmid + (size_t)t * DM, lane, xv);
    const float* m = p.mod + ((size_t)l * 5 + cond_of(t)) * 6144 + 5120 + lane * 16;
#pragma unroll
    for (int q = 0; q < 4; q++) {
      const float4 g = *(const float4*)(m + 4 * q);
      xv[4 * q] += g.x * acc[4 * q]; xv[4 * q + 1] += g.y * acc[4 * q + 1];
      xv[4 * q + 2] += g.z * acc[4 * q + 2]; xv[4 * q + 3] += g.w * acc[4 * q + 3];
    }
    if (l == 0) {
#pragma unroll
      for (int q = 0; q < 4; q++)
        *(float4*)(p.x + (size_t)t * DM + lane * 16 + 4 * q) = make_float4(xv[4 * q], xv[4 * q + 1], xv[4 * q + 2], xv[4 * q + 3]);
      const float* m1 = p.mod + ((size_t)1 * 5 + cond_of(t)) * 6144;
      norm_emit<true>(xv, lane, p.in[9] + DM, m1 + 1024, m1, p.h, t, nullptr);
    } else {
      norm_emit<true>(xv, lane, p.in[32], nullptr, nullptr, nullptr, 0, p.out + (size_t)t * DM);
    }
  }
}

template <int S>
__device__ __forceinline__ void run_stage(const Params& p, int l, char* smem, const Blk& bk) {
  if (S == 0) ph_prologue(p, smem);
  else if (S == 1) ph_norm(p, 0, 0);
  else if (S == 2) ph_gemm_in(p, l, smem, bk);
  else if (S == 3) ph_mixers(p, l, smem);
  else if (S == 4) ph_attn(p, l, smem);
  else if (S == 5) ph_merge(p, l, smem, bk);
  else if (S == 6) ph_out(p, l, smem, bk);
  else if (S == 7) ph_norm(p, l, 1);
  else if (S == 8) ph_peer_q(p, l, smem, bk);
  else if (S == 9) ph_route(p, l, smem);
  else if (S == 10) ph_gather(p, l, smem);
}

template <int S>
__global__ void __launch_bounds__(256, 2) k_stage(Params p, int l) {
  __shared__ __align__(16) char smem[SMEM_BYTES];
  Blk bk; bk.xcd = blockIdx.x & 7; bk.rank = blockIdx.x >> 3; bk.nblk = gridDim.x >> 3;
  run_stage<S>(p, l, smem, bk);
}

__device__ __forceinline__ unsigned at_ld(unsigned* p) { return __hip_atomic_load(p, __ATOMIC_RELAXED, __HIP_MEMORY_SCOPE_AGENT); }
__device__ __forceinline__ unsigned at_add(unsigned* p, unsigned v) { return __hip_atomic_fetch_add(p, v, __ATOMIC_RELAXED, __HIP_MEMORY_SCOPE_AGENT); }
__device__ __forceinline__ void gbar(unsigned* base, int xcd, unsigned nblk_x, unsigned k, bool phys = false) {
  asm volatile("s_waitcnt vmcnt(0)" ::: "memory");
  __syncthreads();
  if (threadIdx.x == 0) {
    if (!phys) {
      __builtin_amdgcn_fence(__ATOMIC_RELEASE, "agent");
      asm volatile("s_waitcnt vmcnt(0)" ::: "memory");
    }
    unsigned* xarr = base + 64 * (1 + xcd);
    unsigned* xgen = base + 64 * (9 + xcd);
    const unsigned prev = at_add(xarr, 1u);
    if (prev == k * nblk_x - 1u) {
      if (phys) {
        __builtin_amdgcn_fence(__ATOMIC_RELEASE, "agent");
        asm volatile("s_waitcnt vmcnt(0)" ::: "memory");
      }
      at_add(base, 1u);
      while (at_ld(base) < 8u * k) __builtin_amdgcn_s_sleep(1);
      __hip_atomic_store(xgen, k, __ATOMIC_RELAXED, __HIP_MEMORY_SCOPE_AGENT);
    } else {
      while (at_ld(xgen) < k) __builtin_amdgcn_s_sleep(2);
    }
    __builtin_amdgcn_fence(__ATOMIC_ACQUIRE, "agent");
    asm volatile("s_waitcnt vmcnt(0)" ::: "memory");
  }
  __syncthreads();
}
#define STAGE(S, L) for (int r_ = 0; r_ < p.reps[S]; r_++) { run_stage<S>(p, L, smem, bk); epoch += 1; gbar(bctr, bk.xcd, (unsigned)bk.nblk, epoch, phys); }
template <int L>
__device__ __forceinline__ void run_layer(const Params& p, char* smem, unsigned* bctr, unsigned& epoch, const Blk& bk, const bool phys) {
  STAGE(2, L) STAGE(3, L) STAGE(4, L) STAGE(5, L) STAGE(6, L) STAGE(7, L) STAGE(8, L) STAGE(9, L) STAGE(10, L)
}
__global__ void __launch_bounds__(256, 2) mega(Params p) {
  __shared__ __align__(16) char smem[SMEM_BYTES];
  cg::grid_group grid = cg::this_grid();
  Blk bk;
  {
    int* sI = (int*)smem;
    if (threadIdx.x == 0) {
      const int x = (int)(__builtin_amdgcn_s_getreg((3 << 11) | 20) & 7u);
      sI[0] = x;
      sI[1] = atomicAdd(&p.xcnt[x], 1);
    }
    __syncthreads();
    bk.xcd = __builtin_amdgcn_readfirstlane(sI[0]);
    bk.rank = __builtin_amdgcn_readfirstlane(sI[1]);
    bk.nblk = 0;
    __syncthreads();
  }
  unsigned* bctr = (unsigned*)p.xcnt + 64;
  unsigned epoch = 0;
  bool phys = false;
  {
    const Blk bk0 = {0, 0, 1};
    run_stage<0>(p, 0, smem, bk0);
    if (p.reps[11] < 0) grid.sync();
    gbar(bctr + 64 * 40, (int)(blockIdx.x & 7), gridDim.x >> 3, 1u);
  }
  {
    int mine = 0, mn = 1 << 30, tot = 0;
#pragma unroll
    for (int x = 0; x < 8; x++) {
      const int c = __hip_atomic_load(&p.xcnt[x], __ATOMIC_RELAXED, __HIP_MEMORY_SCOPE_AGENT);
      mine = (x == bk.xcd) ? c : mine;
      mn = c < mn ? c : mn;
      tot += c;
    }
    phys = mn > 0 && tot == (int)gridDim.x;
    if (phys) bk.nblk = mine;
    else { bk.xcd = blockIdx.x & 7; bk.rank = blockIdx.x >> 3; bk.nblk = gridDim.x >> 3; }
  }
  STAGE(1, 0)
  run_layer<0>(p, smem, bctr, epoch, bk, phys);
  run_layer<1>(p, smem, bctr, epoch, bk, phys);
}

extern "C" void kernel_launch(void* const* d_in, const int* in_sizes, int n_in, void* d_out, int out_size, void* d_ws,
                              size_t ws_size, hipStream_t stream) {
  Params p;
  memset(&p, 0, sizeof(p));
  for (int i = 0; i < 33; i++) p.in[i] = (const float*)d_in[i];
  p.out = (float*)d_out;
  char* w = (char*)d_ws;
  size_t off = 0;
  auto alloc = [&](size_t bytes) { char* r = w + off; off += (bytes + 255) & ~(size_t)255; return r; };
  p.WtIn = (u16*)alloc((size_t)2 * INW * 1024 * 2);
  p.WtUpA = (u16*)alloc((size_t)2 * 524288 * 2);
  p.WtUpB = (u16*)alloc((size_t)2 * 524288 * 2);
  p.WtUpC = (u16*)alloc((size_t)2 * 524288 * 2);
  p.WtOut = (u16*)alloc((size_t)2 * 1048576 * 2);
  p.WtQ = (u16*)alloc((size_t)2 * 2097152 * 2);
  p.KeysB = (u16*)alloc((size_t)2 * 32768 * 2);
  p.AwsB = (u16*)alloc((size_t)2 * 65536 * 2);
  p.LruWt = (u16*)alloc((size_t)2 * 131072 * 2);
  p.PU = (u16*)alloc((size_t)2 * 16384 * 1024);
  p.PV = (u16*)alloc((size_t)2 * 16384 * 1024);
  p.mod = (float*)alloc((size_t)2 * 5 * 6144 * 4);
  p.rope = (float*)alloc((size_t)3072 * 4);
  p.lam = (float*)alloc(256);
  p.x = (float*)alloc((size_t)T_ALL * DM * 4);
  p.h = (u16*)alloc((size_t)T_ALL * DM * 2);
  p.proj = (u16*)alloc((size_t)T_ALL * INW * 2);
  p.hs = (u16*)alloc((size_t)2 * T_ALL * 512 * 2);
  p.ya = (u16*)alloc((size_t)T_ALL * 512 * 2);
  p.yc = (u16*)alloc((size_t)T_ALL * 512 * 2);
  p.Qb = (u16*)alloc((size_t)T_ALL * 512 * 2);
  p.Kb = (u16*)alloc((size_t)7340032 * 2);
  p.Vt = (u16*)alloc((size_t)7340032 * 2);
  p.pidx = (int*)alloc((size_t)T_ALL * 128 * 4);
  p.pgate = (float*)alloc((size_t)T_ALL * 128 * 4);
  p.acum = (u16*)alloc((size_t)2 * T_ALL * 512 * 2);
  p.segtot = (float*)alloc((size_t)4 * 2 * 8 * 2 * 512 * 4);
  p.xcnt = (int*)alloc(16384);
  hipMemsetAsync(p.xcnt, 0, 16384, stream);
  p.yb = (u16*)p.pidx;
  p.xmid = (float*)((char*)p.proj + ((size_t)64 << 20));
  { const int reps[12] = {1, 1, 1, 1, 1, 1, 1, 1, 1, 1, 1, 0}; for (int i = 0; i < 12; i++) p.reps[i] = reps[i]; }
  if (off > ws_size) fprintf(stderr, "workspace too small: need %zu have %zu\n", off, ws_size);
  static int grid_blocks = 0;
  if (!grid_blocks) {
    int dev = 0, cus = 0, per_cu = 0;
    hipGetDevice(&dev);
    hipDeviceGetAttribute(&cus, hipDeviceAttributeMultiprocessorCount, dev);
    hipOccupancyMaxActiveBlocksPerMultiprocessor(&per_cu, mega, 256, 0);
    if (per_cu > 2) per_cu = 2;
    grid_blocks = cus * per_cu;
  }
  void* args[] = {&p};
  hipError_t e = hipLaunchCooperativeKernel((void*)mega, dim3(grid_blocks), dim3(256), args, 0, stream);
  if (e != hipSuccess) fprintf(stderr, "cooperative launch failed: %s (grid %d)\n", hipGetErrorString(e), grid_blocks);
}
```

```cpp
#include <hip/hip_runtime.h>
#include <hip/hip_cooperative_groups.h>
#include <cstdio>
#include <cstdint>
#include <cstring>
namespace cg = cooperative_groups;

typedef unsigned short u16;
typedef __attribute__((ext_vector_type(8))) short bf16x8;
typedef __attribute__((ext_vector_type(16))) float f32x16;

constexpr int T_CTX = 4096, T_ALL = 12288, DM = 1024, INW = 6656;
constexpr int OUT_YS = 4194304, OUT_K = 12582912, OUT_V = 16777216, OUT_LRU = 20971520;
constexpr int SMEM_BYTES = 75776;
constexpr int NPHASE = 20;

struct Params {
  const float* in[33];
  float* out;
  u16 *WtIn, *WtUpA, *WtUpB, *WtUpC, *WtOut, *WtQ, *KeysB, *AwsB, *LruWt, *PU, *PV;
  float *mod, *rope, *lam, *x;
  u16 *h, *proj, *hs, *ya, *yc, *Qb, *Kb, *Vt;
  int* pidx;
  float* pgate;
  u16* yb;
  float* xmid;
  int reps[12];
  int* xcnt;
  u16* acum;
  float* segtot;
};
struct Blk { int xcd, rank, nblk; };


typedef float f32x2_ __attribute__((ext_vector_type(2)));
typedef __bf16 bf16x2_ __attribute__((ext_vector_type(2)));
__device__ __forceinline__ uint32_t pack2(float a, float b) {
  f32x2_ v = {a, b};
  bf16x2_ r = __builtin_convertvector(v, bf16x2_);
  return __builtin_bit_cast(uint32_t, r);
}
__device__ __forceinline__ u16 f2bf(float f) { return (u16)(pack2(f, 0.f) & 0xffffu); }
__device__ __forceinline__ float bf2f(u16 h) { return __uint_as_float(((uint32_t)h) << 16); }
__device__ __forceinline__ float lo2f(uint32_t w) { return __uint_as_float(w << 16); }
__device__ __forceinline__ float hi2f(uint32_t w) { return __uint_as_float(w & 0xffff0000u); }
__device__ __forceinline__ float sigmoidf_(float x) { return __builtin_amdgcn_rcpf(1.f + __expf(-x)); }
__device__ __forceinline__ float gelu_tanh(float x) {
  float u = 0.7978845608028654f * (x + 0.044715f * x * x * x);
  return x * sigmoidf_(2.f * u);
}
__device__ __forceinline__ float wave_sum(float v) {
#pragma unroll
  for (int o = 32; o >= 1; o >>= 1) v += __shfl_xor(v, o);
  return v;
}
__device__ __forceinline__ int get_tid() {
  int t;
  asm volatile("v_mov_b32 %0, %1" : "=v"(t) : "v"((int)threadIdx.x));
  return t;
}
__device__ __forceinline__ size_t blk_off(int t, int c) { return (size_t)(c >> 6) * ((size_t)T_ALL * 64) + (size_t)t * 64 + (c & 63); }
__device__ __forceinline__ const float* in_xrow(const float* xp, const float* xs, int t) {
  return t < T_CTX ? xp + (size_t)t * DM : xs + (size_t)(t - T_CTX) * DM;
}
__device__ __forceinline__ int cond_of(int t) { return t < T_CTX ? 0 : 1 + ((t - T_CTX) >> 11); }
__device__ __forceinline__ float lam_init_of(int l) { return l == 0 ? 0.2f : 0.35550906759f; }

constexpr int LDS_STRIDE = 72;
typedef uint32_t u32x4 __attribute__((ext_vector_type(4)));
__device__ __forceinline__ void gl16(u32x4& r, const u16* p) {
  asm volatile("global_load_dwordx4 %0, %1, off" : "=v"(r) : "v"(p));
}
#define GLDS16(gptr, lptr) \
  __builtin_amdgcn_global_load_lds((const unsigned*)(gptr), (__attribute__((address_space(3))) unsigned*)(lptr), 16, 0, 0)
template <int NJ>
__device__ __forceinline__ void gemm_core(const u16* __restrict__ A, size_t ksA, const u16* __restrict__ Bt, size_t ksB, int K,
                                          f32x16 (&acc)[2][NJ], u16* sA, u16*  ) {
  constexpr int A_BYTES = 16384, B_BYTES = 8192 * NJ, STG_BYTES = A_BYTES + B_BYTES;
  char* lds = (char*)sA;
  const int tid = get_tid(), lane = tid & 63, wave = tid >> 6;
  const int wm = wave >> 1, wn = wave & 1;
  const int r = lane & 31, hh = lane >> 5;
  const int srcoff = (tid >> 3) * 64 + (((tid & 7) ^ ((tid >> 4) & 7)) * 8);
  const u16* ga = A + srcoff;
  const u16* gb = Bt + srcoff;
  char* la = lds + tid * 16;
#define GEMM_ISSUE(STG)                                                                                        \
  {                                                                                                            \
    char* l_ = la + (STG) * STG_BYTES;                                                                         \
    GLDS16(ga, l_); GLDS16(ga + 2048, l_ + 4096); GLDS16(ga + 4096, l_ + 8192); GLDS16(ga + 6144, l_ + 12288); \
    GLDS16(gb, l_ + A_BYTES); GLDS16(gb + 2048, l_ + A_BYTES + 4096);                                          \
    if (NJ == 2) { GLDS16(gb + 4096, l_ + A_BYTES + 8192); GLDS16(gb + 6144, l_ + A_BYTES + 12288); }          \
    ga += ksA; gb += ksB;                                                                                      \
  }
  const int nk = K >> 6;
  const int rswz = (r >> 1) & 7;
  const char* ra = lds + (wm * 64 + r) * 128;
  const char* rb = lds + A_BYTES + (wn * 32 * NJ + r) * 128;
  constexpr int NS = (NJ == 1) ? 3 : 2;
  if (NS == 3) asm volatile("s_waitcnt vmcnt(0)" ::: "memory");
  __syncthreads();
  GEMM_ISSUE(0)
  if (NS == 3) GEMM_ISSUE(1)
  int cs = 0;
  for (int kb = 0; kb < nk; kb++) {
    int cur;
    if (NS == 3) {
      if (kb + 1 < nk) asm volatile("s_waitcnt vmcnt(6)" ::: "memory");
      else asm volatile("s_waitcnt vmcnt(0)" ::: "memory");
      __builtin_amdgcn_s_barrier();
      asm volatile("" ::: "memory");
      cur = cs * STG_BYTES;
      const int ns = cs >= 1 ? cs - 1 : 2;
      if (kb + 2 < nk) GEMM_ISSUE(ns)
      cs = cs == 2 ? 0 : cs + 1;
    } else {
      asm volatile("s_waitcnt vmcnt(0)" ::: "memory");
      __builtin_amdgcn_s_barrier();
      asm volatile("" ::: "memory");
      cur = (kb & 1) * STG_BYTES;
      if (kb + 1 < nk) {
        if (kb & 1) GEMM_ISSUE(0) else GEMM_ISSUE(1)
      }
    }
    __builtin_amdgcn_sched_barrier(0);
    __builtin_amdgcn_s_setprio(1);
#pragma unroll
    for (int ks = 0; ks < 4; ks++) {
      const int co = (((ks * 2 + hh) ^ rswz) << 4) + cur;
      bf16x8 a[2], b[NJ];
#pragma unroll
      for (int i = 0; i < 2; i++) a[i] = *(const bf16x8*)(ra + i * 4096 + co);
#pragma unroll
      for (int j = 0; j < NJ; j++) b[j] = *(const bf16x8*)(rb + j * 4096 + co);
#pragma unroll
      for (int i = 0; i < 2; i++)
#pragma unroll
        for (int j = 0; j < NJ; j++) acc[i][j] = __builtin_amdgcn_mfma_f32_32x32x16_bf16(a[i], b[j], acc[i][j], 0, 0, 0);
    }
    __builtin_amdgcn_s_setprio(0);
  }
#undef GEMM_ISSUE
}
#define ACC_ZERO(acc)                                   \
  _Pragma("unroll") for (int i_ = 0; i_ < 2; i_++)      \
  _Pragma("unroll") for (int j_ = 0; j_ < 2; j_++)      \
  _Pragma("unroll") for (int r_ = 0; r_ < 16; r_++) acc[i_][j_][r_] = 0.f;
#define ACC_ROW(wm, i, r, lane) ((wm) * 64 + (i) * 32 + ((r) & 3) + 8 * ((r) >> 2) + 4 * ((lane) >> 5))
#define ACC_COL(wn, j, lane) ((wn) * 64 + (j) * 32 + ((lane) & 31))

template <int NJ>
__device__ __forceinline__ void stage_tile_bf16(const f32x16 (&acc)[2][NJ], u16* sC, int wm, int wn, int lane) {
  constexpr int CS = 64 * NJ + 8;
#pragma unroll
  for (int i = 0; i < 2; i++)
#pragma unroll
    for (int j = 0; j < NJ; j++)
#pragma unroll
      for (int r = 0; r < 16; r++)
        sC[(wm * 64 + i * 32 + (r & 3) + 8 * (r >> 2) + 4 * (lane >> 5)) * CS + wn * 32 * NJ + j * 32 + (lane & 31)] = f2bf(acc[i][j][r]);
}
template <bool CONTIG = false>
__device__ __forceinline__ void norm_emit(const float (&xv)[16], int lane, const float* __restrict__ gain,
                                          const float* __restrict__ sc, const float* __restrict__ sh, u16* hdst, int t, float* fdst) {
  float ss = 0.f;
#pragma unroll
  for (int e = 0; e < 16; e++) ss += xv[e] * xv[e];
  ss = wave_sum(ss);
  const float rstd = rsqrtf(ss * (1.f / 1024.f) + 1e-6f);
#pragma unroll
  for (int i = 0; i < 2; i++) {
    const int c0 = CONTIG ? lane * 16 + i * 8 : i * 512 + lane * 8;
    float y[8];
#pragma unroll
    for (int j = 0; j < 8; j++) {
      float v = xv[i * 8 + j] * rstd * gain[c0 + j];
      if (sc) v = v * (1.f + sc[c0 + j]) + sh[c0 + j];
      y[j] = v;
    }
    if (hdst) {
      uint4 o;
      o.x = pack2(y[0], y[1]); o.y = pack2(y[2], y[3]); o.z = pack2(y[4], y[5]); o.w = pack2(y[6], y[7]);
      *(uint4*)(hdst + blk_off(t, c0)) = o;
    } else {
      *(float4*)(fdst + c0) = make_float4(y[0], y[1], y[2], y[3]);
      *(float4*)(fdst + c0 + 4) = make_float4(y[4], y[5], y[6], y[7]);
    }
  }
}
template <bool CONTIG = false>
__device__ __forceinline__ void load_row16(const float* __restrict__ xr, int lane, float (&xv)[16]) {
#pragma unroll
  for (int i = 0; i < 2; i++) {
    const int c0 = CONTIG ? lane * 16 + i * 8 : i * 512 + lane * 8;
    float4 a = *(const float4*)(xr + c0);
    float4 b = *(const float4*)(xr + c0 + 4);
    xv[i * 8 + 0] = a.x; xv[i * 8 + 1] = a.y; xv[i * 8 + 2] = a.z; xv[i * 8 + 3] = a.w;
    xv[i * 8 + 4] = b.x; xv[i * 8 + 5] = b.y; xv[i * 8 + 6] = b.z; xv[i * 8 + 7] = b.w;
  }
}

__device__ void tr_tile(const float* __restrict__ src, int R, int C, u16* __restrict__ dst, int tr, int tc, float* sT) {
  const int tid = get_tid();
  const int r0 = tr * 64, c0 = tc * 64;
  __syncthreads();
#pragma unroll
  for (int i = 0; i < 4; i++) {
    int r = (tid >> 4) + 16 * i, c4 = (tid & 15) * 4;
    float4 v = *(const float4*)(src + (size_t)(r0 + r) * C + c0 + c4);
    sT[r * 65 + c4 + 0] = v.x; sT[r * 65 + c4 + 1] = v.y; sT[r * 65 + c4 + 2] = v.z; sT[r * 65 + c4 + 3] = v.w;
  }
  __syncthreads();
  const int c = tid >> 2, rq = (tid & 3) * 16;
  uint32_t w[8];
#pragma unroll
  for (int j = 0; j < 8; j++) w[j] = pack2(sT[(rq + 2 * j) * 65 + c], sT[(rq + 2 * j + 1) * 65 + c]);
  u16* d = dst + (size_t)tr * C * 64 + (size_t)(c0 + c) * 64 + rq;
  *(uint4*)(d) = make_uint4(w[0], w[1], w[2], w[3]);
  *(uint4*)(d + 8) = make_uint4(w[4], w[5], w[6], w[7]);
}
__device__ __forceinline__ void cvt_item(const float* __restrict__ src, u16* __restrict__ dst, size_t item) {
  size_t o = item * 2048 + (size_t)get_tid() * 8;
  float4 a = *(const float4*)(src + o), b = *(const float4*)(src + o + 4);
  *(uint4*)(dst + o) = make_uint4(pack2(a.x, a.y), pack2(a.z, a.w), pack2(b.x, b.y), pack2(b.z, b.w));
}

typedef float f32x2 __attribute__((ext_vector_type(2)));
__device__ __forceinline__ void cvt8_item(const float* __restrict__ src, unsigned char* __restrict__ dst, size_t item, float scale) {
  const size_t o = item * 8192 + (size_t)get_tid() * 8;
  float4 a[4], b[4];
#pragma unroll
  for (int q = 0; q < 4; q++) { a[q] = *(const float4*)(src + o + q * 2048); b[q] = *(const float4*)(src + o + q * 2048 + 4); }
#pragma unroll
  for (int q = 0; q < 4; q++) {
    int w0 = __builtin_amdgcn_cvt_pk_fp8_f32(a[q].x * scale, a[q].y * scale, 0, false);
    w0 = __builtin_amdgcn_cvt_pk_fp8_f32(a[q].z * scale, a[q].w * scale, w0, true);
    int w1 = __builtin_amdgcn_cvt_pk_fp8_f32(b[q].x * scale, b[q].y * scale, 0, false);
    w1 = __builtin_amdgcn_cvt_pk_fp8_f32(b[q].z * scale, b[q].w * scale, w1, true);
    *(uint2*)(dst + o + q * 2048) = make_uint2((uint32_t)w0, (uint32_t)w1);
  }
}
__device__ __forceinline__ void cvt4_item(const float* __restrict__ src, unsigned char* __restrict__ dst, size_t item, float scale) {
  const size_t o = item * 8192 + (size_t)get_tid() * 8;
  float4 a[4], b[4];
#pragma unroll
  for (int q = 0; q < 4; q++) { a[q] = *(const float4*)(src + o + q * 2048); b[q] = *(const float4*)(src + o + q * 2048 + 4); }
#pragma unroll
  for (int q = 0; q < 4; q++) {
    unsigned w = 0;
    w = __builtin_amdgcn_cvt_scalef32_pk_fp4_f32(w, a[q].x * scale, a[q].y * scale, 1.0f, 0);
    w = __builtin_amdgcn_cvt_scalef32_pk_fp4_f32(w, a[q].z * scale, a[q].w * scale, 1.0f, 1);
    w = __builtin_amdgcn_cvt_scalef32_pk_fp4_f32(w, b[q].x * scale, b[q].y * scale, 1.0f, 2);
    w = __builtin_amdgcn_cvt_scalef32_pk_fp4_f32(w, b[q].z * scale, b[q].w * scale, 1.0f, 3);
    *(uint32_t*)(dst + ((o + q * 2048) >> 1)) = w;
  }
}
constexpr bool U_FP4 = true, V_FP4 = true;
constexpr float PU_SCALE = U_FP4 ? 48.f : 64.f, PV_SCALE = V_FP4 ? 6.f : 8.f;
constexpr int PU_ROWB = U_FP4 ? 512 : 1024, PV_ROWB = V_FP4 ? 512 : 1024;
__device__ void ph_prologue(const Params& p, char* smem) {
  const int tid = get_tid();
  float* sf = (float*)smem;
  constexpr int N_MODI = 384, N_MISC = 1, N_TR = 5696, N_KEYS = 32, N_AWS = 64, N_X = 0, N_PU = 4096, N_PV = 4096;
  constexpr int B_MISC = N_MODI, B_TR = B_MISC + N_MISC, B_KEYS = B_TR + N_TR, B_AWS = B_KEYS + N_KEYS, B_X = B_AWS + N_AWS,
                B_PU = B_X + N_X, B_PV = B_PU + N_PU, N_TOTAL = B_PV + N_PV;
  for (int it = blockIdx.x; it < N_TOTAL; it += gridDim.x) {
    if (it < N_MODI) {
      const int l = it / 192, n0 = (it % 192) * 32;
      __syncthreads();
      for (int e = tid; e < 5 * 1024; e += 256) {
        int c = e >> 10, k = e & 1023;
        float v = (c == 0) ? p.in[6][k] : p.in[5][(c - 1) * 1024 + k];
        sf[e] = v * sigmoidf_(v);
      }
      __syncthreads();
      const int col4 = (tid & 7) * 4, kg = tid >> 3;
      const float* w = p.in[7] + (size_t)l * 1024 * 6144 + n0 + col4;
      float a[5][4];
#pragma unroll
      for (int c = 0; c < 5; c++)
#pragma unroll
        for (int q = 0; q < 4; q++) a[c][q] = 0.f;
#pragma unroll 8
      for (int k = kg * 32; k < kg * 32 + 32; k++) {
        const float4 wv = *(const float4*)(w + (size_t)k * 6144);
#pragma unroll
        for (int c = 0; c < 5; c++) {
          const float sv = sf[c * 1024 + k];
          a[c][0] += sv * wv.x; a[c][1] += sv * wv.y; a[c][2] += sv * wv.z; a[c][3] += sv * wv.w;
        }
      }
      float* sr = sf + 5120;
#pragma unroll
      for (int c = 0; c < 5; c++)
#pragma unroll
        for (int q = 0; q < 4; q++) sr[(kg * 5 + c) * 32 + col4 + q] = a[c][q];
      __syncthreads();
      for (int e = tid; e < 160; e += 256) {
        int c = e >> 5, cc = e & 31;
        float sm = 0.f;
#pragma unroll
        for (int g = 0; g < 32; g++) sm += sr[(g * 5 + c) * 32 + cc];
        p.mod[((size_t)l * 5 + c) * 6144 + n0 + cc] = sm + p.in[8][l * 6144 + n0 + cc];
      }
    } else if (it < B_TR) {
      for (int e = tid; e < 1536; e += 256) {
        int pos, f;
        if (e < 512) { pos = e >> 4; f = e & 15; } else { pos = (e - 512) >> 4; f = (e - 512) & 15; }
        float inv = powf(10000.f, -(float)f / 16.f);
        float ang = (float)pos * inv;
        p.rope[2 * e] = cosf(ang);
        p.rope[2 * e + 1] = sinf(ang);
      }
      if (tid < 128) {
        int l = tid >> 6, i = tid & 63;
        const float* lp = p.in[22] + l * 256;
        float s1 = wave_sum(lp[i] * lp[64 + i]);
        float s2 = wave_sum(lp[128 + i] * lp[192 + i]);
        if (i == 0) p.lam[l] = expf(s1) - expf(s2) + lam_init_of(l);
      }
    } else if (it < B_KEYS) {
      int j = it - B_TR;
      const int l = j / 2848; j -= l * 2848;
      if (j < 1664) tr_tile(p.in[11] + (size_t)l * 1024 * INW, 1024, INW, p.WtIn + (size_t)l * INW * 1024, j / 104, j % 104, sf);
      else if (j < 1792) { j -= 1664; tr_tile(p.in[24] + (size_t)l * 524288, 512, 1024, p.WtUpA + (size_t)l * 524288, j / 16, j % 16, sf); }
      else if (j < 1920) { j -= 1792; tr_tile(p.in[25] + (size_t)l * 524288, 512, 1024, p.WtUpB + (size_t)l * 524288, j / 16, j % 16, sf); }
      else if (j < 2048) { j -= 1920; tr_tile(p.in[26] + (size_t)l * 524288, 512, 1024, p.WtUpC + (size_t)l * 524288, j / 16, j % 16, sf); }
      else if (j < 2304) { j -= 2048; tr_tile(p.in[27] + (size_t)l * 1048576, 1024, 1024, p.WtOut + (size_t)l * 1048576, j / 16, j % 16, sf); }
      else if (j < 2816) { j -= 2304; tr_tile(p.in[28] + (size_t)l * 2097152, 1024, 2048, p.WtQ + (size_t)l * 2097152, j / 32, j % 32, sf); }
      else {
        j -= 2816;
        const int ri = j >> 4, dh = j & 15;
        tr_tile(p.in[ri ? 19 : 17] + (size_t)l * 65536 + dh * 4096, 64, 64, p.LruWt + (size_t)l * 131072 + (ri * 16 + dh) * 4096, 0, 0, sf);
      }
    } else if (it < B_AWS) {
      cvt_item(p.in[29], p.KeysB, it - B_KEYS);
    } else if (it < B_X) {
      cvt_item(p.in[13], p.AwsB, it - B_AWS);
    } else if (it < B_PV) {
      if (U_FP4) cvt4_item(p.in[30], (unsigned char*)p.PU, it - B_PU, PU_SCALE);
      else cvt8_item(p.in[30], (unsigned char*)p.PU, it - B_PU, PU_SCALE);
    } else {
      if (V_FP4) cvt4_item(p.in[31], (unsigned char*)p.PV, it - B_PV, PV_SCALE);
      else cvt8_item(p.in[31], (unsigned char*)p.PV, it - B_PV, PV_SCALE);
    }
  }
}

__device__ void ph_norm(const Params& p, int l, int which) {
  const int tid_ = get_tid(), lane = tid_ & 63, wave = tid_ >> 6;
  for (int t = blockIdx.x * 4 + wave; t < T_ALL; t += gridDim.x * 4) {
    float xv[16];
    load_row16(which == 0 ? in_xrow(p.in[0], p.in[1], t) : p.xmid + (size_t)t * DM, lane, xv);
    const float* m = p.mod + ((size_t)l * 5 + cond_of(t)) * 6144;
    if (which == 0) norm_emit(xv, lane, p.in[9] + l * DM, m + 1024, m, p.h, t, nullptr);
    else norm_emit(xv, lane, p.in[10] + l * DM, m + 4096, m + 3072, p.h, t, nullptr);
  }
}

__device__ void ph_gemm_in(const Params& p, int l, char* smem, const Blk& bk) {
  u16* sA = (u16*)smem; u16* sB = sA + 2 * 128 * LDS_STRIDE;
  const int tid_ = get_tid(), lane = tid_ & 63, wave = tid_ >> 6, wm = wave >> 1, wn = wave & 1;
  constexpr int NT = INW / 128;
  const int xcd = bk.xcd;
  for (int lt = bk.rank; lt < 12 * NT; lt += bk.nblk) {
    const int mt = xcd * 12 + lt % 12, nt = lt / 12;
    f32x16 acc[2][2];
    ACC_ZERO(acc);
    gemm_core<2>(p.h + (size_t)mt * 128 * 64, (size_t)T_ALL * 64, p.WtIn + (size_t)l * INW * DM + (size_t)nt * 128 * 64, (size_t)INW * 64, DM, acc, sA, sB);
    __syncthreads();
    stage_tile_bf16<2>(acc, sA, wm, wn, lane);
    __syncthreads();
    {
      const int tid = wave * 64 + lane;
#pragma unroll
      for (int q = 0; q < 8; q++) {
        const int idx = tid + 256 * q, row = idx >> 4, ch = idx & 15;
        *(uint4*)(p.proj + (size_t)(mt * 128 + row) * INW + nt * 128 + ch * 8) = *(const uint4*)(sA + row * 136 + ch * 8);
      }
    }
    if (mt * 128 < T_CTX && nt * 128 >= 2560 && nt * 128 < 3584) {
      float* ob = p.out + (nt * 128 < 3072 ? OUT_K - 2560 : OUT_V - 3072);
#pragma unroll
      for (int i = 0; i < 2; i++)
#pragma unroll
        for (int j = 0; j < 2; j++) {
          const int n = nt * 128 + ACC_COL(wn, j, lane);
#pragma unroll
          for (int r = 0; r < 16; r++) {
            const int t = mt * 128 + ACC_ROW(wm, i, r, lane);
            const int b = t >> 8, sq = t & 255;
            ob[((size_t)(b * 2 + l) * 256 + sq) * 512 + n] = acc[i][j][r];
          }
        }
    }
  }
}

__device__ void item_chunk_mlp(const Params& p, int l, int chunk, int g, char* smem) {
  const int tid = get_tid(), lane = tid & 63, wave = tid >> 6, wm = wave >> 1, wn = wave & 1;
  u16* sVt = (u16*)smem;
  float* sR = (float*)(smem + 128 * 136 * 2);
  const int t0 = chunk * 128;
  __syncthreads();
  {
    const int q = tid >> 1, hf = tid & 1;
    const u16* vp = p.proj + (size_t)(t0 + q) * INW + 512 + hf * 256;
    float ss = 0.f;
#pragma unroll 4
    for (int i = 0; i < 32; i++) {
      uint4 w = *(const uint4*)(vp + i * 8);
      float a;
      a = lo2f(w.x); ss += a * a; a = hi2f(w.x); ss += a * a;
      a = lo2f(w.y); ss += a * a; a = hi2f(w.y); ss += a * a;
      a = lo2f(w.z); ss += a * a; a = hi2f(w.z); ss += a * a;
      a = lo2f(w.w); ss += a * a; a = hi2f(w.w); ss += a * a;
    }
    ss += __shfl_xor(ss, 1);
    if (hf == 0) sR[q] = rsqrtf(ss * (1.f / 512.f) + 1e-6f);
  }
  __syncthreads();
  {
    const int q = tid >> 1, cb = (tid & 1) * 64;
    const float rs = sR[q];
    const u16* vp = p.proj + (size_t)(t0 + q) * INW + 512 + g * 128 + cb;
    const float* gv = p.in[12] + l * 512 + g * 128 + cb;
#pragma unroll
    for (int i = 0; i < 8; i++) {
      uint4 w = *(const uint4*)(vp + i * 8);
      uint32_t ww[4] = {w.x, w.y, w.z, w.w};
#pragma unroll
      for (int j = 0; j < 4; j++) {
        int c = cb + i * 8 + 2 * j;
        sVt[c * 136 + q] = f2bf(lo2f(ww[j]) * rs * gv[i * 8 + 2 * j]);
        sVt[(c + 1) * 136 + q] = f2bf(hi2f(ww[j]) * rs * gv[i * 8 + 2 * j + 1]);
      }
    }
  }
  __syncthreads();
  const u16* Aw = p.AwsB + (size_t)l * 65536 + g * 16384;
  f32x16 acc[2][2];
  ACC_ZERO(acc);
#pragma unroll
  for (int ks = 0; ks < 8; ks++) {
    bf16x8 a[2], b[2];
#pragma unroll
    for (int i = 0; i < 2; i++) {
      a[i] = *(const bf16x8*)(Aw + (wm * 64 + i * 32 + (lane & 31)) * 128 + ks * 16 + (lane >> 5) * 8);
      b[i] = *(const bf16x8*)(sVt + (wn * 64 + i * 32 + (lane & 31)) * 136 + ks * 16 + (lane >> 5) * 8);
    }
#pragma unroll
    for (int i = 0; i < 2; i++)
#pragma unroll
      for (int j = 0; j < 2; j++) acc[i][j] = __builtin_amdgcn_mfma_f32_32x32x16_bf16(a[i], b[j], acc[i][j], 0, 0, 0);
  }
  __syncthreads();
  float* sM = (float*)smem;
#pragma unroll
  for (int i = 0; i < 2; i++)
#pragma unroll
    for (int j = 0; j < 2; j++)
#pragma unroll
      for (int r = 0; r < 16; r++) sM[ACC_ROW(wm, i, r, lane) * 132 + ACC_COL(wn, j, lane)] = acc[i][j][r];
  __syncthreads();
  {
    const int pp = tid >> 1, cb = (tid & 1) * 64;
    const float bsv = p.in[14][l * 512 + g * 128 + pp];
    const u16* up = p.proj + (size_t)(t0 + pp) * INW + g * 128 + cb;
    u16* yp = p.ya + blk_off(t0 + pp, g * 128 + cb);
    const float* mp = sM + pp * 132 + cb;
#pragma unroll 2
    for (int i = 0; i < 8; i++) {
      const uint4 w = *(const uint4*)(up + i * 8);
      const float4 m0 = *(const float4*)(mp + i * 8), m1 = *(const float4*)(mp + i * 8 + 4);
      uint4 o;
      o.x = pack2(lo2f(w.x) * (m0.x + bsv), hi2f(w.x) * (m0.y + bsv));
      o.y = pack2(lo2f(w.y) * (m0.z + bsv), hi2f(w.y) * (m0.w + bsv));
      o.z = pack2(lo2f(w.z) * (m1.x + bsv), hi2f(w.z) * (m1.y + bsv));
      o.w = pack2(lo2f(w.w) * (m1.z + bsv), hi2f(w.w) * (m1.w + bsv));
      *(uint4*)(yp + i * 8) = o;
    }
  }
}

__device__ void item_lru(const Params& p, int l, int seq, int seg, int d, int hb, char* smem) {
  const int tid = get_tid(), lane = tid & 63, wave = tid >> 6;
  float* sXf = (float*)smem;
  float* sA_ = sXf + 64 * 65;
  float* sBx = sA_ + 64 * 65;
  float* sPar = sBx + 64 * 65;
  u16* sXb = (u16*)(sPar + 512);
  const bool lat = seq >= 16;
  const int L = lat ? 2048 : 256;
  const int tok0 = lat ? T_CTX + (seq - 16) * 2048 : seq * 256;
  __syncthreads();
  if (tid < 64) {
    const int ch = hb * 64 + tid;
#pragma unroll
    for (int j = 0; j < 4; j++) sPar[j * 64 + tid] = p.in[15][l * 2048 + j * 512 + ch];
    sPar[256 + tid] = p.in[16][l * 512 + ch];
    const float lm = p.in[21][(l * 2 + d) * 512 + ch];
    sPar[320 + tid] = (-lm > 20.f) ? -lm : log1pf(expf(-lm));
    sPar[384 + tid] = p.in[18][(l * 2 + d) * 512 + ch];
    sPar[448 + tid] = p.in[20][(l * 2 + d) * 512 + ch];
  }
  const int th = wave & 1, nt = wave >> 1;
  bf16x8 wr[4], wi[4];
  {
    const u16* Wr = p.LruWt + (size_t)l * 131072 + ((0 * 2 + d) * 8 + hb) * 4096;
    const u16* Wi = p.LruWt + (size_t)l * 131072 + ((1 * 2 + d) * 8 + hb) * 4096;
#pragma unroll
    for (int ks = 0; ks < 4; ks++) {
      wr[ks] = *(const bf16x8*)(Wr + (nt * 32 + (lane & 31)) * 64 + ks * 16 + (lane >> 5) * 8);
      wi[ks] = *(const bf16x8*)(Wi + (nt * 32 + (lane & 31)) * 64 + ks * 16 + (lane >> 5) * 8);
    }
  }
  float hstate = 0.f, acum = 1.f;
  u16* acg = p.acum + (size_t)d * T_ALL * 512;
  u16* hs = p.hs + (size_t)d * T_ALL * 512;
  __syncthreads();
  const int r = tid >> 2, cq = (tid & 3) * 16;
  for (int ti = 0; ti < 4; ti++) {
    const int pos = seg * 256 + ti * 64 + r;
    const int ts = d == 0 ? pos : L - 1 - pos;
    {
      float xc[16];
#pragma unroll
      for (int c = 0; c < 16; c++) xc[c] = sPar[256 + cq + c];
#pragma unroll
      for (int j = 0; j < 4; j++) {
        const int tt = ts + j - 2;
        if (tt >= 0 && tt < L) {
          const u16* xp = p.proj + (size_t)(tok0 + tt) * INW + 1024 + hb * 64 + cq;
          uint4 w0 = *(const uint4*)xp, w1 = *(const uint4*)(xp + 8);
          uint32_t ww[8] = {w0.x, w0.y, w0.z, w0.w, w1.x, w1.y, w1.z, w1.w};
#pragma unroll
          for (int c = 0; c < 8; c++) {
            xc[2 * c] += lo2f(ww[c]) * sPar[j * 64 + cq + 2 * c];
            xc[2 * c + 1] += hi2f(ww[c]) * sPar[j * 64 + cq + 2 * c + 1];
          }
        }
      }
#pragma unroll
      for (int c = 0; c < 16; c++) sXf[r * 65 + cq + c] = xc[c];
      uint4 o0 = make_uint4(pack2(xc[0], xc[1]), pack2(xc[2], xc[3]), pack2(xc[4], xc[5]), pack2(xc[6], xc[7]));
      uint4 o1 = make_uint4(pack2(xc[8], xc[9]), pack2(xc[10], xc[11]), pack2(xc[12], xc[13]), pack2(xc[14], xc[15]));
      *(uint4*)(sXb + r * 72 + cq) = o0;
      *(uint4*)(sXb + r * 72 + cq + 8) = o1;
    }
    __syncthreads();
    {
      f32x16 ar, ai;
#pragma unroll
      for (int q = 0; q < 16; q++) { ar[q] = 0.f; ai[q] = 0.f; }
#pragma unroll
      for (int ks = 0; ks < 4; ks++) {
        bf16x8 a = *(const bf16x8*)(sXb + (th * 32 + (lane & 31)) * 72 + ks * 16 + (lane >> 5) * 8);
        ar = __builtin_amdgcn_mfma_f32_32x32x16_bf16(a, wr[ks], ar, 0, 0, 0);
        ai = __builtin_amdgcn_mfma_f32_32x32x16_bf16(a, wi[ks], ai, 0, 0, 0);
      }
      const int ch = nt * 32 + (lane & 31);
      const float sp = sPar[320 + ch], br_ = sPar[384 + ch], bi_ = sPar[448 + ch];
#pragma unroll
      for (int q = 0; q < 16; q++) {
        const int tk = th * 32 + (q & 3) + 8 * (q >> 2) + 4 * (lane >> 5);
        const float rr = sigmoidf_(ar[q] + br_), ii = sigmoidf_(ai[q] + bi_);
        const float la = -8.f * rr * sp;
        const float a = __expf(la);
        const float om = fmaxf(1.f - __expf(2.f * la), 0.f);
        sA_[tk * 65 + ch] = a;
        sBx[tk * 65 + ch] = __builtin_amdgcn_sqrtf(om) * ii * sXf[tk * 65 + ch];
      }
    }
    __syncthreads();
    if (tid < 64) {
#pragma unroll 8
      for (int q = 0; q < 64; q++) {
        const float a = sA_[q * 65 + tid];
        hstate = a * hstate + sBx[q * 65 + tid];
        acum *= a;
        sBx[q * 65 + tid] = hstate;
        sA_[q * 65 + tid] = acum;
      }
    }
    __syncthreads();
    {
      float v[16];
#pragma unroll
      for (int c = 0; c < 16; c++) v[c] = sBx[r * 65 + cq + c];
      u16* dp = hs + (size_t)(tok0 + ts) * 512 + hb * 64 + cq;
      *(uint4*)dp = make_uint4(pack2(v[0], v[1]), pack2(v[2], v[3]), pack2(v[4], v[5]), pack2(v[6], v[7]));
      *(uint4*)(dp + 8) = make_uint4(pack2(v[8], v[9]), pack2(v[10], v[11]), pack2(v[12], v[13]), pack2(v[14], v[15]));
      if (lat) {
#pragma unroll
        for (int c = 0; c < 16; c++) v[c] = sA_[r * 65 + cq + c];
        u16* ap = acg + (size_t)(tok0 + ts) * 512 + hb * 64 + cq;
        *(uint4*)ap = make_uint4(pack2(v[0], v[1]), pack2(v[2], v[3]), pack2(v[4], v[5]), pack2(v[6], v[7]));
        *(uint4*)(ap + 8) = make_uint4(pack2(v[8], v[9]), pack2(v[10], v[11]), pack2(v[12], v[13]), pack2(v[14], v[15]));
      }
    }
    __syncthreads();
  }
  if (tid < 64) {
    if (!lat) p.out[OUT_LRU + ((seq * 2 + l) * 2 + d) * 512 + hb * 64 + tid] = hstate;
    else {
      float* st = p.segtot + ((((size_t)(seq - 16) * 2 + d) * 8 + seg) * 2) * 512 + hb * 64 + tid;
      st[0] = acum;
      st[512] = hstate;
    }
  }
}

__device__ __forceinline__ size_t kv_base(int seq) { return seq < 16 ? (size_t)seq * 131072 : (size_t)2097152 + (size_t)(seq - 16) * 1310720; }
__device__ __forceinline__ int kperm(int pp) { return 8 * ((pp & 7) >> 2) + 4 * (pp >> 3) + (pp & 3); }

template <bool CACHE>
__device__ void item_prep(const Params& p, int l, int seq, int tile, char* smem) {
  const int tid = get_tid();
  u16* sV = (u16*)smem;
  const bool lat = seq >= 16;
  const int NK = lat ? 2560 : 256;
  const int L = lat ? 2048 : 256;
  const int tok0 = lat ? T_CTX + (seq - 16) * 2048 : seq * 256;
  const int s0 = tile * 64;
  const int key0 = CACHE ? 2048 + s0 : s0;
  const size_t base = kv_base(seq);
  (void)L;
  if (!CACHE) {
    for (int u = tid; u < 2048; u += 256) {
      const int rr = u >> 5, vid = (u >> 1) & 15, ax = u & 1;
      const int isk = vid >> 3, head = (vid >> 1) & 3, half = vid & 1;
      const int s = s0 + rr;
      const u16* src = p.proj + (size_t)(tok0 + s) * INW + (isk ? 2560 : 2048) + head * 128 + half * 64 + ax * 32;
      uint4 w[4];
#pragma unroll
      for (int i = 0; i < 4; i++) w[i] = *(const uint4*)(src + i * 8);
      uint32_t ww[16] = {w[0].x, w[0].y, w[0].z, w[0].w, w[1].x, w[1].y, w[1].z, w[1].w,
                         w[2].x, w[2].y, w[2].z, w[2].w, w[3].x, w[3].y, w[3].z, w[3].w};
      float x1[16], x2[16];
#pragma unroll
      for (int i = 0; i < 8; i++) {
        x1[2 * i] = lo2f(ww[i]); x1[2 * i + 1] = hi2f(ww[i]);
        x2[2 * i] = lo2f(ww[8 + i]); x2[2 * i + 1] = hi2f(ww[8 + i]);
      }
      const float scl = isk ? 1.f : 0.125f * 1.4426950408889634f;
      float o1[16], o2[16];
      if (lat) {
        const float* tab = ax == 0 ? p.rope + 2 * ((s >> 6) * 16) : p.rope + 2 * (512 + (s & 63) * 16);
#pragma unroll
        for (int i = 0; i < 16; i++) {
          const float cs = tab[2 * i], sn = tab[2 * i + 1];
          o1[i] = (x1[i] * cs - x2[i] * sn) * scl;
          o2[i] = (x1[i] * sn + x2[i] * cs) * scl;
        }
      } else {
#pragma unroll
        for (int i = 0; i < 16; i++) { o1[i] = x1[i] * scl; o2[i] = x2[i] * scl; }
      }
      u16* dst = isk ? p.Kb + base + ((size_t)(head * 2 + half) * NK + s) * 64 + ax * 32
                     : p.Qb + (size_t)(tok0 + s) * 512 + head * 128 + half * 64 + ax * 32;
      *(uint4*)(dst) = make_uint4(pack2(o1[0], o1[1]), pack2(o1[2], o1[3]), pack2(o1[4], o1[5]), pack2(o1[6], o1[7]));
      *(uint4*)(dst + 8) = make_uint4(pack2(o1[8], o1[9]), pack2(o1[10], o1[11]), pack2(o1[12], o1[13]), pack2(o1[14], o1[15]));
      *(uint4*)(dst + 16) = make_uint4(pack2(o2[0], o2[1]), pack2(o2[2], o2[3]), pack2(o2[4], o2[5]), pack2(o2[6], o2[7]));
      *(uint4*)(dst + 24) = make_uint4(pack2(o2[8], o2[9]), pack2(o2[10], o2[11]), pack2(o2[12], o2[13]), pack2(o2[14], o2[15]));
    }
  } else {
    const float* ck = p.in[2] + ((size_t)((seq - 16) * 2 + l) * 512 + s0) * 512;
    for (int u = tid; u < 4096; u += 256) {
      const int rr = u >> 6, head = (u >> 4) & 3, half = (u >> 3) & 1, c8 = u & 7;
      const float* src = ck + (size_t)rr * 512 + head * 128 + half * 64 + c8 * 8;
      float4 a = *(const float4*)src, b = *(const float4*)(src + 4);
      u16* dst = p.Kb + base + ((size_t)(head * 2 + half) * NK + key0 + rr) * 64 + c8 * 8;
      *(uint4*)dst = make_uint4(pack2(a.x, a.y), pack2(a.z, a.w), pack2(b.x, b.y), pack2(b.z, b.w));
    }
  }
  for (int head = 0; head < 4; head++) {
    __syncthreads();
    for (int u = tid; u < 1024; u += 256) {
      const int rr = u >> 4, c8 = u & 15;
      uint4 o;
      if (CACHE) {
        const float* src = p.in[3] + ((size_t)((seq - 16) * 2 + l) * 512 + s0 + rr) * 512 + head * 128 + c8 * 8;
        float4 a = *(const float4*)src, b = *(const float4*)(src + 4);
        o = make_uint4(pack2(a.x, a.y), pack2(a.z, a.w), pack2(b.x, b.y), pack2(b.z, b.w));
      } else {
        o = *(const uint4*)(p.proj + (size_t)(tok0 + s0 + rr) * INW + 3072 + head * 128 + c8 * 8);
      }
      *(uint4*)(sV + rr * 136 + c8 * 8) = o;
    }
    __syncthreads();
    {
      const int dv = tid >> 1, kb0 = (tid & 1) * 2;
#pragma unroll
      for (int kk = 0; kk < 2; kk++) {
        const int kb = kb0 + kk;
        uint32_t w[8];
#pragma unroll
        for (int pp = 0; pp < 8; pp++) {
          const u16 a = sV[(kb * 16 + kperm(2 * pp)) * 136 + dv];
          const u16 b = sV[(kb * 16 + kperm(2 * pp + 1)) * 136 + dv];
          w[pp] = (uint32_t)a | ((uint32_t)b << 16);
        }
        u16* dst = p.Vt + base + (size_t)head * 128 * NK + (size_t)((key0 + kb * 16) >> 5) * 4096 + dv * 32 + (kb & 1) * 16;
        *(uint4*)dst = make_uint4(w[0], w[1], w[2], w[3]);
        *(uint4*)(dst + 8) = make_uint4(w[4], w[5], w[6], w[7]);
      }
    }
  }
}

__device__ void ph_mixers(const Params& p, int l, char* smem) {
  for (int it0 = blockIdx.x; it0 < 768 + 608; it0 += gridDim.x) {
    const int it = it0 < 768 ? it0 : it0 - 768 + 320;
    if (it0 < 512) item_lru(p, l, 16 + (it0 >> 7), (it0 >> 4) & 7, (it0 >> 3) & 1, it0 & 7, smem);
    else if (it0 < 768) { int j = it0 - 512; item_lru(p, l, j >> 4, 0, (j >> 3) & 1, j & 7, smem); }
    else if (it < 704) { int j = it - 320; item_chunk_mlp(p, l, j >> 2, j & 3, smem); }
    else if (it < 896) {
      int j = it - 704;
      if (j < 64) item_prep<false>(p, l, j >> 2, j & 3, smem);
      else { j -= 64; item_prep<false>(p, l, 16 + (j >> 5), j & 31, smem); }
    } else { int j = it - 896; item_prep<true>(p, l, 16 + (j >> 3), j & 7, smem); }
  }
}

__device__ void item_attn(const Params& p, int l, int seq, int head, int qb, char* smem) {
  const int tid_ = get_tid(), lane = tid_ & 63, wave = tid_ >> 6;
  const int qs = wave >> 1, hf = wave & 1;
  float* sO = (float*)smem;
  const bool lat = seq >= 16;
  const int NK = lat ? 2560 : 256;
  const int tok0 = lat ? T_CTX + (seq - 16) * 2048 : seq * 256;
  const size_t base = kv_base(seq);
  const int q0 = qb * 64 + qs * 32;
  const int ql = lane & 31, hh = lane >> 5;
  bf16x8 qf[4];
#pragma unroll
  for (int ks = 0; ks < 4; ks++)
    qf[ks] = *(const bf16x8*)(p.Qb + (size_t)(tok0 + q0 + ql) * 512 + head * 128 + hf * 64 + ks * 16 + hh * 8);
  f32x16 O[4];
#pragma unroll
  for (int mt = 0; mt < 4; mt++)
#pragma unroll
    for (int r = 0; r < 16; r++) O[mt][r] = 0.f;
  float m_ = 0.f, l_ = 0.f;
  f32x16 negm;
#pragma unroll
  for (int r = 0; r < 16; r++) negm[r] = 0.f;
  constexpr int KST = 64 * 72, VST = 128 * 40, STG = KST + VST;
  u16* sKV = (u16*)smem;
  const int tid = wave * 64 + lane;
  const u16* Kg0 = p.Kb + base + (size_t)(head * 2) * NK * 64 + tid * 8;
  const u16* Kg1 = Kg0 + (size_t)NK * 64;
  const u16* Vg = p.Vt + base + (size_t)head * 128 * NK + tid * 8;
  u16* wk0 = sKV + ((tid >> 3) & 31) * 72 + (tid & 7) * 8;
  u16* wk1 = wk0 + 32 * 72;
  u16* wv0 = sKV + KST + (tid >> 2) * 40 + (tid & 3) * 8;
  u16* wv1 = wv0 + 64 * 40;
  const u16* rk = sKV + (hf * 32 + ql) * 72 + hh * 8;
  const u16* rv = sKV + KST + ql * 40 + hh * 8;
#define BC(x) __builtin_bit_cast(bf16x8, x)
#define LD4(p) (*(const u32x4*)(p))
  const int nkt = NK / 32;
  u32x4 gk0 = LD4(Kg0), gk1 = LD4(Kg1), gv0 = LD4(Vg), gv1 = LD4(Vg + 2048);
  __syncthreads();
  *(u32x4*)wk0 = gk0; *(u32x4*)wk1 = gk1; *(u32x4*)wv0 = gv0; *(u32x4*)wv1 = gv1;
  {
    const int k1 = nkt > 1 ? 1 : 0;
    gk0 = LD4(Kg0 + (size_t)k1 * 2048); gk1 = LD4(Kg1 + (size_t)k1 * 2048);
    gv0 = LD4(Vg + (size_t)k1 * 4096); gv1 = LD4(Vg + (size_t)k1 * 4096 + 2048);
  }
  for (int kt = 0; kt < nkt; kt++) {
    __syncthreads();
    const int cur = (kt & 1) * STG, nxt = STG - cur;
    if (kt + 1 < nkt) {
      *(u32x4*)(wk0 + nxt) = gk0; *(u32x4*)(wk1 + nxt) = gk1; *(u32x4*)(wv0 + nxt) = gv0; *(u32x4*)(wv1 + nxt) = gv1;
    }
    {
      const int k2 = (kt + 2 < nkt) ? kt + 2 : nkt - 1;
      gk0 = LD4(Kg0 + (size_t)k2 * 2048); gk1 = LD4(Kg1 + (size_t)k2 * 2048);
      gv0 = LD4(Vg + (size_t)k2 * 4096); gv1 = LD4(Vg + (size_t)k2 * 4096 + 2048);
    }
    __builtin_amdgcn_sched_barrier(0);
    const bf16x8 kc0 = *(const bf16x8*)(rk + cur), kc1 = *(const bf16x8*)(rk + cur + 16), kc2 = *(const bf16x8*)(rk + cur + 32),
                 kc3 = *(const bf16x8*)(rk + cur + 48);
    const bf16x8 v0 = *(const bf16x8*)(rv + cur), v1 = *(const bf16x8*)(rv + cur + 16);
    const bf16x8 v2 = *(const bf16x8*)(rv + cur + 32 * 40), v3 = *(const bf16x8*)(rv + cur + 32 * 40 + 16);
    const bf16x8 v4 = *(const bf16x8*)(rv + cur + 64 * 40), v5 = *(const bf16x8*)(rv + cur + 64 * 40 + 16);
    const bf16x8 v6 = *(const bf16x8*)(rv + cur + 96 * 40), v7 = *(const bf16x8*)(rv + cur + 96 * 40 + 16);
    f32x16 s = __builtin_amdgcn_mfma_f32_32x32x16_bf16(kc0, qf[0], negm, 0, 0, 0);
    s = __builtin_amdgcn_mfma_f32_32x32x16_bf16(kc1, qf[1], s, 0, 0, 0);
    s = __builtin_amdgcn_mfma_f32_32x32x16_bf16(kc2, qf[2], s, 0, 0, 0);
    s = __builtin_amdgcn_mfma_f32_32x32x16_bf16(kc3, qf[3], s, 0, 0, 0);
    float mx = fmaxf(s[0], s[1]);
#pragma unroll
    for (int r = 2; r < 16; r += 2) mx = fmaxf(mx, fmaxf(s[r], s[r + 1]));
    mx = fmaxf(mx, __shfl_xor(mx, 32));
    if (kt == 0 || __builtin_amdgcn_ballot_w64(mx > 8.f) != 0ull) {
      const float d = kt == 0 ? mx : fmaxf(mx, 0.f);
      const float alpha = kt == 0 ? 1.f : __builtin_amdgcn_exp2f(-d);
      l_ *= alpha;
      m_ += d;
#pragma unroll
      for (int r = 0; r < 16; r++) { s[r] -= d; negm[r] = -m_; }
#pragma unroll
      for (int mt = 0; mt < 4; mt++)
#pragma unroll
        for (int r = 0; r < 16; r++) O[mt][r] *= alpha;
    }
    float rs = 0.f;
#pragma unroll
    for (int r = 0; r < 16; r++) { s[r] = __builtin_amdgcn_exp2f(s[r]); rs += s[r]; }
    rs += __shfl_xor(rs, 32);
    l_ += rs;
    bf16x8 pf0, pf1;
    {
      typedef uint32_t u32x4_ __attribute__((ext_vector_type(4)));
      u32x4_ w0, w1;
      w0[0] = pack2(s[0], s[1]); w0[1] = pack2(s[2], s[3]); w0[2] = pack2(s[4], s[5]); w0[3] = pack2(s[6], s[7]);
      w1[0] = pack2(s[8], s[9]); w1[1] = pack2(s[10], s[11]); w1[2] = pack2(s[12], s[13]); w1[3] = pack2(s[14], s[15]);
      pf0 = __builtin_bit_cast(bf16x8, w0);
      pf1 = __builtin_bit_cast(bf16x8, w1);
    }
    O[0] = __builtin_amdgcn_mfma_f32_32x32x16_bf16(v0, pf0, O[0], 0, 0, 0);
    O[0] = __builtin_amdgcn_mfma_f32_32x32x16_bf16(v1, pf1, O[0], 0, 0, 0);
    O[1] = __builtin_amdgcn_mfma_f32_32x32x16_bf16(v2, pf0, O[1], 0, 0, 0);
    O[1] = __builtin_amdgcn_mfma_f32_32x32x16_bf16(v3, pf1, O[1], 0, 0, 0);
    O[2] = __builtin_amdgcn_mfma_f32_32x32x16_bf16(v4, pf0, O[2], 0, 0, 0);
    O[2] = __builtin_amdgcn_mfma_f32_32x32x16_bf16(v5, pf1, O[2], 0, 0, 0);
    O[3] = __builtin_amdgcn_mfma_f32_32x32x16_bf16(v6, pf0, O[3], 0, 0, 0);
    O[3] = __builtin_amdgcn_mfma_f32_32x32x16_bf16(v7, pf1, O[3], 0, 0, 0);
    __builtin_amdgcn_sched_barrier(0);
  }
  const float lam = p.lam[l];
  const float sc = hf == 0 ? 1.f / l_ : lam / l_;
  __syncthreads();
  if (hf == 1) {
#pragma unroll
    for (int mt = 0; mt < 4; mt++)
#pragma unroll
      for (int r = 0; r < 16; r++) sO[(qs * 64 + mt * 16 + r) * 64 + lane] = O[mt][r] * sc;
  }
  __syncthreads();
  if (hf == 0) {
    float ss = 0.f;
#pragma unroll
    for (int mt = 0; mt < 4; mt++)
#pragma unroll
      for (int r = 0; r < 16; r++) {
        const float o = O[mt][r] * sc - sO[(qs * 64 + mt * 16 + r) * 64 + lane];
        O[mt][r] = o;
        ss += o * o;
      }
    ss += __shfl_xor(ss, 32);
    const float rstd = rsqrtf(ss * (1.f / 128.f) + 1e-6f) * (1.f - lam_init_of(l));
    const float* sub = p.in[23] + l * 128;
    const int tq = tok0 + q0 + ql;
#pragma unroll
    for (int mt = 0; mt < 4; mt++)
#pragma unroll
      for (int g = 0; g < 4; g++) {
        const int dv = mt * 32 + 8 * g + 4 * hh;
        const float4 sb = *(const float4*)(sub + dv);
        uint2 o;
        o.x = pack2(O[mt][4 * g] * rstd * sb.x, O[mt][4 * g + 1] * rstd * sb.y);
        o.y = pack2(O[mt][4 * g + 2] * rstd * sb.z, O[mt][4 * g + 3] * rstd * sb.w);
        *(uint2*)(p.yc + blk_off(tq, head * 128 + dv)) = o;
      }
  }
}

__device__ void ph_attn(const Params& p, int l, char* smem) {
  for (int it = blockIdx.x; it < 768 + 384; it += gridDim.x) {
    if (it < 512) item_attn(p, l, 16 + (it >> 7), (it >> 5) & 3, it & 31, smem);
    else if (it < 768) { int j = it - 512; item_attn(p, l, j >> 4, (j >> 2) & 3, j & 3, smem); }
    else {
      const int tid = get_tid();
      const int c = (tid & 63) * 8, tl = tid >> 6;
      const int t0 = (it - 768) * 32;
      float hinf[8], hinb[8];
#pragma unroll
      for (int j = 0; j < 8; j++) { hinf[j] = 0.f; hinb[j] = 0.f; }
      const bool latc = t0 >= T_CTX;
      if (latc) {
        const int sq = (t0 - T_CTX) >> 11, spos = (t0 - T_CTX) & 2047;
#pragma unroll
        for (int d = 0; d < 2; d++) {
          const int sg = (d == 0 ? spos : 2047 - spos) >> 8;
          float hin[8];
          const float* h0 = p.in[4] + ((sq * 2 + l) * 2 + d) * 512 + c;
#pragma unroll
          for (int j = 0; j < 8; j++) hin[j] = h0[j];
          const float* st = p.segtot + (((size_t)sq * 2 + d) * 8) * 2 * 512 + c;
          for (int j2 = 0; j2 < sg; j2++) {
            const float4 a0 = *(const float4*)(st + j2 * 1024), a1 = *(const float4*)(st + j2 * 1024 + 4);
            const float4 b0 = *(const float4*)(st + j2 * 1024 + 512), b1 = *(const float4*)(st + j2 * 1024 + 516);
            hin[0] = a0.x * hin[0] + b0.x; hin[1] = a0.y * hin[1] + b0.y; hin[2] = a0.z * hin[2] + b0.z; hin[3] = a0.w * hin[3] + b0.w;
            hin[4] = a1.x * hin[4] + b1.x; hin[5] = a1.y * hin[5] + b1.y; hin[6] = a1.z * hin[6] + b1.z; hin[7] = a1.w * hin[7] + b1.w;
          }
#pragma unroll
          for (int j = 0; j < 8; j++) { if (d == 0) hinf[j] = hin[j]; else hinb[j] = hin[j]; }
        }
      }
#pragma unroll 2
      for (int i = 0; i < 8; i++) {
        const int t = t0 + tl + 4 * i;
        const size_t o = (size_t)t * 512 + c;
        const uint4 f = *(const uint4*)(p.hs + o), b = *(const uint4*)(p.hs + (size_t)T_ALL * 512 + o);
        const uint4 g = *(const uint4*)(p.proj + (size_t)t * INW + 1536 + c);
        float hv[8];
        hv[0] = lo2f(f.x) + lo2f(b.x); hv[1] = hi2f(f.x) + hi2f(b.x); hv[2] = lo2f(f.y) + lo2f(b.y); hv[3] = hi2f(f.y) + hi2f(b.y);
        hv[4] = lo2f(f.z) + lo2f(b.z); hv[5] = hi2f(f.z) + hi2f(b.z); hv[6] = lo2f(f.w) + lo2f(b.w); hv[7] = hi2f(f.w) + hi2f(b.w);
        if (latc) {
          const uint4 af = *(const uint4*)(p.acum + o), ab = *(const uint4*)(p.acum + (size_t)T_ALL * 512 + o);
          hv[0] += lo2f(af.x) * hinf[0] + lo2f(ab.x) * hinb[0]; hv[1] += hi2f(af.x) * hinf[1] + hi2f(ab.x) * hinb[1];
          hv[2] += lo2f(af.y) * hinf[2] + lo2f(ab.y) * hinb[2]; hv[3] += hi2f(af.y) * hinf[3] + hi2f(ab.y) * hinb[3];
          hv[4] += lo2f(af.z) * hinf[4] + lo2f(ab.z) * hinb[4]; hv[5] += hi2f(af.z) * hinf[5] + hi2f(ab.z) * hinb[5];
          hv[6] += lo2f(af.w) * hinf[6] + lo2f(ab.w) * hinb[6]; hv[7] += hi2f(af.w) * hinf[7] + hi2f(ab.w) * hinb[7];
        }
        uint4 oo;
        oo.x = pack2(hv[0] * gelu_tanh(lo2f(g.x)), hv[1] * gelu_tanh(hi2f(g.x)));
        oo.y = pack2(hv[2] * gelu_tanh(lo2f(g.y)), hv[3] * gelu_tanh(hi2f(g.y)));
        oo.z = pack2(hv[4] * gelu_tanh(lo2f(g.z)), hv[5] * gelu_tanh(hi2f(g.z)));
        oo.w = pack2(hv[6] * gelu_tanh(lo2f(g.w)), hv[7] * gelu_tanh(hi2f(g.w)));
        *(uint4*)(p.yb + blk_off(t, c)) = oo;
      }
    }
  }
}

__device__ void ph_merge(const Params& p, int l, char* smem, const Blk& bk) {
  u16* sA = (u16*)smem; u16* sB = sA + 2 * 128 * LDS_STRIDE;
  const int tid_ = get_tid(), lane = tid_ & 63, wave = tid_ >> 6, wm = wave >> 1, wn = wave & 1;
  const int xcd = bk.xcd;
  for (int lt = bk.rank; lt < 12 * 16; lt += bk.nblk) {
    const int mt = xcd * 12 + lt % 12, nt = lt / 12;
    const int n = nt * 64 + wn * 32 + (lane & 31);
    f32x16 mg[2][1];
#pragma unroll
    for (int i = 0; i < 2; i++)
#pragma unroll
      for (int r = 0; r < 16; r++) mg[i][0][r] = 0.f;
#pragma unroll 1
    for (int br = 0; br < 3; br++) {
      const u16* A = (br == 0 ? p.ya : br == 1 ? p.yb : p.yc) + (size_t)mt * 128 * 64;
      const u16* W = (br == 0 ? p.WtUpA : br == 1 ? p.WtUpB : p.WtUpC) + (size_t)l * 524288 + (size_t)nt * 64 * 64;
      f32x16 acc[2][1];
#pragma unroll
      for (int i = 0; i < 2; i++)
#pragma unroll
        for (int r = 0; r < 16; r++) acc[i][0][r] = 0.f;
      gemm_core<1>(A, (size_t)T_ALL * 64, W, (size_t)1024 * 64, 512, acc, sA, sB);
      __syncthreads();
      {
        const int tid = get_tid();
#pragma unroll
        for (int q = 0; q < 4; q++) {
          const int row = (tid >> 3) + 32 * q, c8 = (tid & 7) * 8;
          *(uint4*)(sA + row * LDS_STRIDE + c8) =
              *(const uint4*)(p.proj + (size_t)(mt * 128 + row) * INW + 3584 + br * 1024 + nt * 64 + c8);
        }
      }
      __syncthreads();
#pragma unroll
      for (int i = 0; i < 2; i++)
#pragma unroll
        for (int r = 0; r < 16; r++) {
          const int row = ACC_ROW(wm, i, r, lane);
          const float g = sigmoidf_(bf2f(sA[row * LDS_STRIDE + wn * 32 + (lane & 31)]));
          mg[i][0][r] += g * acc[i][0][r];
        }
    }
    __syncthreads();
    stage_tile_bf16<1>(mg, sA, wm, wn, lane);
    __syncthreads();
    {
      const int tid = wave * 64 + lane;
      u16* dst = p.h + blk_off(mt * 128, nt * 64);
#pragma unroll
      for (int q = 0; q < 4; q++) {
        const int idx = tid + 256 * q, row = idx >> 3, ch = idx & 7;
        *(uint4*)(dst + row * 64 + ch * 8) = *(const uint4*)(sA + row * 72 + ch * 8);
      }
    }
  }
}

__device__ void ph_out(const Params& p, int l, char* smem, const Blk& bk) {
  u16* sA = (u16*)smem; u16* sB = sA + 2 * 128 * LDS_STRIDE;
  const int tid_ = get_tid(), lane = tid_ & 63, wave = tid_ >> 6, wm = wave >> 1, wn = wave & 1;
  const int xcd = bk.xcd;
  for (int lt = bk.rank; lt < 12 * 16; lt += bk.nblk) {
    const int mt = xcd * 12 + lt % 12, nt = lt / 12;
    f32x16 acc[2][1];
#pragma unroll
    for (int i = 0; i < 2; i++)
#pragma unroll
      for (int r = 0; r < 16; r++) acc[i][0][r] = 0.f;
    gemm_core<1>(p.h + (size_t)mt * 128 * 64, (size_t)T_ALL * 64, p.WtOut + (size_t)l * 1048576 + (size_t)nt * 64 * 64, (size_t)1024 * 64, DM, acc, sA, sB);
    __syncthreads();
    float* sF = (float*)smem;
#pragma unroll
    for (int i = 0; i < 2; i++)
#pragma unroll
      for (int r = 0; r < 16; r++) sF[ACC_ROW(wm, i, r, lane) * 68 + wn * 32 + (lane & 31)] = acc[i][0][r];
    __syncthreads();
    {
      const int tid = wave * 64 + lane;
      const float* gm = p.mod + ((size_t)l * 5 + cond_of(mt * 128)) * 6144 + 2048 + nt * 64;
#pragma unroll
      for (int q = 0; q < 8; q++) {
        const int idx = tid + 256 * q, row = idx >> 4, c4 = (idx & 15) * 4;
        const int t = mt * 128 + row;
        const float* xr = (l == 0 ? in_xrow(p.in[0], p.in[1], t) : p.x + (size_t)t * DM) + nt * 64 + c4;
        const float4 xv = *(const float4*)xr, g = *(const float4*)(gm + c4), a = *(const float4*)(sF + row * 68 + c4);
        *(float4*)(p.xmid + (size_t)t * DM + nt * 64 + c4) = make_float4(xv.x + g.x * a.x, xv.y + g.y * a.y, xv.z + g.z * a.z, xv.w + g.w * a.w);
      }
    }
  }
}

__device__ void ph_peer_q(const Params& p, int l, char* smem, const Blk& bk) {
  u16* sA = (u16*)smem; u16* sB = sA + 2 * 128 * LDS_STRIDE;
  const int tid_ = get_tid(), lane = tid_ & 63, wave = tid_ >> 6, wm = wave >> 1, wn = wave & 1;
  u16* pq = p.proj;
  const int xcd = bk.xcd;
  for (int lt = bk.rank; lt < 12 * 16; lt += bk.nblk) {
    const int mt = xcd * 12 + lt % 12, nt = lt / 12;
    f32x16 acc[2][2];
    ACC_ZERO(acc);
    gemm_core<2>(p.h + (size_t)mt * 128 * 64, (size_t)T_ALL * 64, p.WtQ + (size_t)l * 2097152 + (size_t)nt * 128 * 64, (size_t)2048 * 64, DM, acc, sA, sB);
    __syncthreads();
    stage_tile_bf16<2>(acc, sA, wm, wn, lane);
    __syncthreads();
    {
      const int tid = wave * 64 + lane;
#pragma unroll
      for (int q = 0; q < 8; q++) {
        const int idx = tid + 256 * q, row = idx >> 4, ch = idx & 15;
        *(uint4*)(pq + (size_t)(mt * 128 + row) * 2048 + nt * 128 + ch * 8) = *(const uint4*)(sA + row * 136 + ch * 8);
      }
    }
  }
}

__device__ __forceinline__ void ins16(float (&lst)[16], float v) {
#pragma unroll
  for (int j = 0; j < 16; j++) {
    const float hi = fmaxf(lst[j], v);
    v = fminf(lst[j], v);
    lst[j] = hi;
  }
}
template <int CTRL>
__device__ __forceinline__ float dppf(float v) {
  return __uint_as_float((uint32_t)__builtin_amdgcn_update_dpp(0, (int)__float_as_uint(v), CTRL, 0xf, 0xf, true));
}
template <int CTRL>
__device__ __forceinline__ void merge16(float (&lst)[16]) {
  float o[16];
#pragma unroll
  for (int j = 0; j < 16; j++) o[j] = dppf<CTRL>(lst[j]);
#pragma unroll
  for (int j = 0; j < 16; j++) lst[j] = fmaxf(lst[j], o[15 - j]);
#define BSTAGE(ST)                                                                    \
  _Pragma("unroll") for (int i = 0; i < 16; i++)                                       \
    if ((i & ST) == 0) {                                                               \
      const float hi = fmaxf(lst[i], lst[i + ST]), lo = fminf(lst[i], lst[i + ST]);    \
      lst[i] = hi; lst[i + ST] = lo;                                                   \
    }
  BSTAGE(8) BSTAGE(4) BSTAGE(2) BSTAGE(1)
#undef BSTAGE
}
__device__ void ph_route(const Params& p, int l, char* smem) {
  const int tid = get_tid(), lane = tid & 63, wave = tid >> 6;
  float* sS = (float*)smem;
  uint32_t* sTop = (uint32_t*)(sS + 2 * 64 * 129);
  const u16* pq = p.proj;
  for (int it = blockIdx.x; it < 192 * 8; it += gridDim.x) {
    const int tt = it >> 3, head = it & 7;
    const int t0 = tt * 64;
    __syncthreads();
    {
      const int half = wave & 1, kh = wave >> 1;
      const u16* A = pq + (size_t)t0 * 2048 + head * 256 + half * 128;
      const u16* B = p.KeysB + (size_t)l * 32768 + half * 16384 + (size_t)kh * 64 * 128;
      f32x16 acc[2][2];
      ACC_ZERO(acc);
#pragma unroll
      for (int ks = 0; ks < 8; ks++) {
        bf16x8 a[2], b[2];
#pragma unroll
        for (int i = 0; i < 2; i++) {
          a[i] = *(const bf16x8*)(A + (size_t)(i * 32 + (lane & 31)) * 2048 + ks * 16 + (lane >> 5) * 8);
          b[i] = *(const bf16x8*)(B + (i * 32 + (lane & 31)) * 128 + ks * 16 + (lane >> 5) * 8);
        }
#pragma unroll
        for (int i = 0; i < 2; i++)
#pragma unroll
          for (int j = 0; j < 2; j++) acc[i][j] = __builtin_amdgcn_mfma_f32_32x32x16_bf16(a[i], b[j], acc[i][j], 0, 0, 0);
      }
#pragma unroll
      for (int i = 0; i < 2; i++)
#pragma unroll
        for (int j = 0; j < 2; j++) {
          const int key = kh * 64 + j * 32 + (lane & 31);
#pragma unroll
          for (int r = 0; r < 16; r++) {
            const int tk = i * 32 + (r & 3) + 8 * (r >> 2) + 4 * (lane >> 5);
            sS[(half * 64 + tk) * 129 + key] = acc[i][j][r];
          }
        }
    }
    __syncthreads();
    {
      const int tokl = lane >> 2, sub = lane & 3, half = sub >> 1, part = sub & 1;
      const int tok = wave * 16 + tokl;
      const float* row = sS + (half * 64 + tok) * 129 + part * 64;
      float lst[16];
#pragma unroll
      for (int j = 0; j < 16; j++) lst[j] = -3.0e38f;
#pragma unroll 4
      for (int k = 0; k < 64; k++) {
        const float v = __uint_as_float((__float_as_uint(row[k]) & 0xffffff80u) | (uint32_t)(part * 64 + k));
        ins16(lst, v);
      }
      merge16<0xB1>(lst);
      float a[16], b[16];
#pragma unroll
      for (int j = 0; j < 16; j++) {
        const float o = dppf<0x4E>(lst[j]);
        a[j] = half ? o : lst[j];
        b[j] = half ? lst[j] : o;
      }
      float cl[16];
#pragma unroll
      for (int j = 0; j < 16; j++) cl[j] = -3.0e38f;
      {
        float val = -3.0e38f;
        int c = 0;
#pragma unroll
        for (int i = 0; i < 16; i++)
#pragma unroll
          for (int j = 0; j < 16; j++)
            if ((i + 1) * (j + 1) <= 16) {
              const float sm = __uint_as_float(__float_as_uint(a[i]) & 0xffffff80u) + __uint_as_float(__float_as_uint(b[j]) & 0xffffff80u);
              const float pv = __uint_as_float((__float_as_uint(sm) & 0xffffff00u) | (uint32_t)(i * 16 + j));
              val = ((c & 3) == sub) ? pv : val;
              if ((c & 3) == 3) { ins16(cl, val); val = -3.0e38f; }
              c++;
            }
        ins16(cl, val);
      }
      merge16<0xB1>(cl);
      merge16<0x4E>(cl);
      float mx = -3.0e38f;
#pragma unroll
      for (int j = 0; j < 16; j++) mx = fmaxf(mx, __uint_as_float(__float_as_uint(cl[j]) & 0xffffff00u));
      float sum = 0.f;
#pragma unroll
      for (int j = 0; j < 16; j++) sum += __expf(__uint_as_float(__float_as_uint(cl[j]) & 0xffffff00u) - mx);
      const float inv = __builtin_amdgcn_rcpf(sum);
      int* ip = p.pidx + (size_t)(t0 + tok) * 128 + head * 16 + sub * 4;
      float* gp = p.pgate + (size_t)(t0 + tok) * 128 + head * 16 + sub * 4;
      const uint32_t sm0 = sub == 0 ? 0xffffffffu : 0u, sm1 = sub == 1 ? 0xffffffffu : 0u, sm2 = sub == 2 ? 0xffffffffu : 0u,
                     sm3 = sub == 3 ? 0xffffffffu : 0u;
#pragma unroll
      for (int jj = 0; jj < 4; jj++) {
        const float ent = __uint_as_float((__float_as_uint(cl[jj]) & sm0) | (__float_as_uint(cl[4 + jj]) & sm1) |
                                          (__float_as_uint(cl[8 + jj]) & sm2) | (__float_as_uint(cl[12 + jj]) & sm3));
        const uint32_t code = __float_as_uint(ent) & 0xffu;
        const int ci = code >> 4, cj = code & 15;
        uint32_t ai = 0, bj = 0;
#pragma unroll
        for (int q = 0; q < 16; q++) { ai = (ci == q) ? __float_as_uint(a[q]) : ai; bj = (cj == q) ? __float_as_uint(b[q]) : bj; }
        ip[jj] = (int)((ai & 127u) * 128u + (bj & 127u));
        gp[jj] = __expf(__uint_as_float(__float_as_uint(ent) & 0xffffff00u) - mx) * inv;
      }
    }
  }
}

__device__ __forceinline__ float dot16_fp8(const uint4& w, const float (&hx)[16]) {
  float s = 0.f;
  f32x2 a;
  a = __builtin_amdgcn_cvt_pk_f32_fp8((int)w.x, false); s += a.x * hx[0] + a.y * hx[1];
  a = __builtin_amdgcn_cvt_pk_f32_fp8((int)w.x, true);  s += a.x * hx[2] + a.y * hx[3];
  a = __builtin_amdgcn_cvt_pk_f32_fp8((int)w.y, false); s += a.x * hx[4] + a.y * hx[5];
  a = __builtin_amdgcn_cvt_pk_f32_fp8((int)w.y, true);  s += a.x * hx[6] + a.y * hx[7];
  a = __builtin_amdgcn_cvt_pk_f32_fp8((int)w.z, false); s += a.x * hx[8] + a.y * hx[9];
  a = __builtin_amdgcn_cvt_pk_f32_fp8((int)w.z, true);  s += a.x * hx[10] + a.y * hx[11];
  a = __builtin_amdgcn_cvt_pk_f32_fp8((int)w.w, false); s += a.x * hx[12] + a.y * hx[13];
  a = __builtin_amdgcn_cvt_pk_f32_fp8((int)w.w, true);  s += a.x * hx[14] + a.y * hx[15];
  return s;
}
__device__ __forceinline__ float dot16_fp4(const uint2& w, const f32x2 (&hx2)[8]) {
  f32x2 s = __builtin_amdgcn_cvt_scalef32_pk_f32_fp4(w.x, 1.0f, 0) * hx2[0];
  s += __builtin_amdgcn_cvt_scalef32_pk_f32_fp4(w.x, 1.0f, 1) * hx2[1];
  s += __builtin_amdgcn_cvt_scalef32_pk_f32_fp4(w.x, 1.0f, 2) * hx2[2];
  s += __builtin_amdgcn_cvt_scalef32_pk_f32_fp4(w.x, 1.0f, 3) * hx2[3];
  s += __builtin_amdgcn_cvt_scalef32_pk_f32_fp4(w.y, 1.0f, 0) * hx2[4];
  s += __builtin_amdgcn_cvt_scalef32_pk_f32_fp4(w.y, 1.0f, 1) * hx2[5];
  s += __builtin_amdgcn_cvt_scalef32_pk_f32_fp4(w.y, 1.0f, 2) * hx2[6];
  s += __builtin_amdgcn_cvt_scalef32_pk_f32_fp4(w.y, 1.0f, 3) * hx2[7];
  return s.x + s.y;
}
__device__ __forceinline__ void axpy16_fp4(const uint2& w, float c, f32x2 (&acc2)[8]) {
  const f32x2 c2 = {c, c};
  acc2[0] += c2 * __builtin_amdgcn_cvt_scalef32_pk_f32_fp4(w.x, 1.0f, 0);
  acc2[1] += c2 * __builtin_amdgcn_cvt_scalef32_pk_f32_fp4(w.x, 1.0f, 1);
  acc2[2] += c2 * __builtin_amdgcn_cvt_scalef32_pk_f32_fp4(w.x, 1.0f, 2);
  acc2[3] += c2 * __builtin_amdgcn_cvt_scalef32_pk_f32_fp4(w.x, 1.0f, 3);
  acc2[4] += c2 * __builtin_amdgcn_cvt_scalef32_pk_f32_fp4(w.y, 1.0f, 0);
  acc2[5] += c2 * __builtin_amdgcn_cvt_scalef32_pk_f32_fp4(w.y, 1.0f, 1);
  acc2[6] += c2 * __builtin_amdgcn_cvt_scalef32_pk_f32_fp4(w.y, 1.0f, 2);
  acc2[7] += c2 * __builtin_amdgcn_cvt_scalef32_pk_f32_fp4(w.y, 1.0f, 3);
}
__device__ __forceinline__ void axpy16_fp8(const uint4& w, float c, float (&acc)[16]) {
  f32x2 a;
  a = __builtin_amdgcn_cvt_pk_f32_fp8((int)w.x, false); acc[0] += c * a.x; acc[1] += c * a.y;
  a = __builtin_amdgcn_cvt_pk_f32_fp8((int)w.x, true);  acc[2] += c * a.x; acc[3] += c * a.y;
  a = __builtin_amdgcn_cvt_pk_f32_fp8((int)w.y, false); acc[4] += c * a.x; acc[5] += c * a.y;
  a = __builtin_amdgcn_cvt_pk_f32_fp8((int)w.y, true);  acc[6] += c * a.x; acc[7] += c * a.y;
  a = __builtin_amdgcn_cvt_pk_f32_fp8((int)w.z, false); acc[8] += c * a.x; acc[9] += c * a.y;
  a = __builtin_amdgcn_cvt_pk_f32_fp8((int)w.z, true);  acc[10] += c * a.x; acc[11] += c * a.y;
  a = __builtin_amdgcn_cvt_pk_f32_fp8((int)w.w, false); acc[12] += c * a.x; acc[13] += c * a.y;
  a = __builtin_amdgcn_cvt_pk_f32_fp8((int)w.w, true);  acc[14] += c * a.x; acc[15] += c * a.y;
}
__device__ __forceinline__ float reduce16(const float (&part)[16], int b5, int b4, int b3, int b2) {
  float p8[8], p4[4], p2[2], p1;
#pragma unroll
  for (int i = 0; i < 8; i++) {
    const float keep = b5 ? part[8 + i] : part[i], send = b5 ? part[i] : part[8 + i];
    p8[i] = keep + __shfl_xor(send, 32);
  }
#pragma unroll
  for (int i = 0; i < 4; i++) {
    const float keep = b4 ? p8[4 + i] : p8[i], send = b4 ? p8[i] : p8[4 + i];
    p4[i] = keep + __shfl_xor(send, 16);
  }
#pragma unroll
  for (int i = 0; i < 2; i++) {
    const float keep = b3 ? p4[2 + i] : p4[i], send = b3 ? p4[i] : p4[2 + i];
    p2[i] = keep + __shfl_xor(send, 8);
  }
  {
    const float keep = b2 ? p2[1] : p2[0], send = b2 ? p2[0] : p2[1];
    p1 = keep + __shfl_xor(send, 4);
  }
  p1 += __shfl_xor(p1, 2);
  p1 += __shfl_xor(p1, 1);
  return p1;
}
__device__ void ph_gather(const Params& p, int l, char* smem) {
  const int tid_ = get_tid(), lane = tid_ & 63, wave = tid_ >> 6;
  const unsigned char* PU = (const unsigned char*)p.PU + (size_t)l * 16384 * PU_ROWB;
  const unsigned char* PV = (const unsigned char*)p.PV + (size_t)l * 16384 * PV_ROWB;
  const int b5 = (lane >> 5) & 1, b4 = (lane >> 4) & 1, b3 = (lane >> 3) & 1, b2 = (lane >> 2) & 1;
  for (int t = blockIdx.x * 4 + wave; t < T_ALL; t += gridDim.x * 4) {
    float hx[16];
    {
      const u16* hr = p.h + blk_off(t, lane * 16);
      uint4 w0 = *(const uint4*)(hr), w1 = *(const uint4*)(hr + 8);
      hx[0] = lo2f(w0.x); hx[1] = hi2f(w0.x); hx[2] = lo2f(w0.y); hx[3] = hi2f(w0.y);
      hx[4] = lo2f(w0.z); hx[5] = hi2f(w0.z); hx[6] = lo2f(w0.w); hx[7] = hi2f(w0.w);
      hx[8] = lo2f(w1.x); hx[9] = hi2f(w1.x); hx[10] = lo2f(w1.y); hx[11] = hi2f(w1.y);
      hx[12] = lo2f(w1.z); hx[13] = hi2f(w1.z); hx[14] = lo2f(w1.w); hx[15] = hi2f(w1.w);
    }
    float acc[16];
#pragma unroll
    for (int j = 0; j < 16; j++) acc[j] = 0.f;
    f32x2 hx2[8], acc2[8];
#pragma unroll
    for (int j = 0; j < 8; j++) { hx2[j][0] = hx[2 * j]; hx2[j][1] = hx[2 * j + 1]; acc2[j][0] = 0.f; acc2[j][1] = 0.f; }
    const int me = (lane >> 2) & 15;
    float* sW = (float*)smem + wave * 512;
    if (U_FP4) {
#pragma unroll 1
      for (int head = 0; head < 8; head += 2) {
        const int myidx = p.pidx[(size_t)t * 128 + head * 16 + (lane & 31)];
        float pa[16], pb[16];
        {
          uint2 w[32];
#pragma unroll
          for (int e = 0; e < 32; e++) {
            const int idx = __builtin_amdgcn_readlane(myidx, e);
            w[e] = *(const uint2*)(PU + (size_t)idx * 512 + lane * 8);
          }
          __builtin_amdgcn_sched_barrier(0);
#pragma unroll
          for (int e = 0; e < 16; e++) { pa[e] = dot16_fp4(w[e], hx2); pb[e] = dot16_fp4(w[16 + e], hx2); }
          __builtin_amdgcn_sched_barrier(0);
        }
        const float ra = reduce16(pa, b5, b4, b3, b2), rb = reduce16(pb, b5, b4, b3, b2);
        sW[head * 64 + lane] = p.pgate[(size_t)t * 128 + head * 16 + me] * gelu_tanh(ra * (1.f / PU_SCALE)) * (1.f / PV_SCALE);
        sW[(head + 1) * 64 + lane] = p.pgate[(size_t)t * 128 + (head + 1) * 16 + me] * gelu_tanh(rb * (1.f / PU_SCALE)) * (1.f / PV_SCALE);
        __builtin_amdgcn_sched_barrier(0);
      }
    } else {
#pragma unroll 1
      for (int head = 0; head < 8; head++) {
        const int myidx = p.pidx[(size_t)t * 128 + head * 16 + (lane & 15)];
        float part[16];
#pragma unroll
        for (int eg = 0; eg < 2; eg++) {
          uint4 w[8];
#pragma unroll
          for (int e = 0; e < 8; e++) {
            const int idx = __builtin_amdgcn_readlane(myidx, eg * 8 + e);
            w[e] = *(const uint4*)(PU + (size_t)idx * 1024 + lane * 16);
          }
#pragma unroll
          for (int e = 0; e < 8; e++) part[eg * 8 + e] = dot16_fp8(w[e], hx);
          __builtin_amdgcn_sched_barrier(0);
        }
        const float p1 = reduce16(part, b5, b4, b3, b2);
        sW[head * 64 + lane] = p.pgate[(size_t)t * 128 + head * 16 + me] * gelu_tanh(p1 * (1.f / PU_SCALE)) * (1.f / PV_SCALE);
        __builtin_amdgcn_sched_barrier(0);
      }
    }
#pragma unroll 1
    for (int head = 0; head < 8; head += (V_FP4 ? 2 : 1)) {
      const int myidx = p.pidx[(size_t)t * 128 + head * 16 + (lane & 31)];
      const float wgh = sW[head * 64 + lane];
      if (V_FP4) {
        const float wgh1 = sW[(head + 1) * 64 + lane];
        uint2 w[32];
#pragma unroll
        for (int e = 0; e < 32; e++) {
          const int idx = __builtin_amdgcn_readlane(myidx, e);
          w[e] = *(const uint2*)(PV + (size_t)idx * 512 + lane * 8);
        }
        __builtin_amdgcn_sched_barrier(0);
#pragma unroll
        for (int e = 0; e < 32; e++) {
          const float c = __uint_as_float(__builtin_amdgcn_readlane(__float_as_uint(e < 16 ? wgh : wgh1), 4 * (e & 15)));
          axpy16_fp4(w[e], c, acc2);
        }
      } else {
        uint4 w[16];
#pragma unroll
        for (int e = 0; e < 16; e++) {
          const int idx = __builtin_amdgcn_readlane(myidx, e);
          w[e] = *(const uint4*)(PV + (size_t)idx * 1024 + lane * 16);
        }
        __builtin_amdgcn_sched_barrier(0);
#pragma unroll
        for (int e = 0; e < 16; e++) {
          const float c = __uint_as_float(__builtin_amdgcn_readlane(__float_as_uint(wgh), 4 * e));
          axpy16_fp8(w[e], c, acc);
        }
      }
      __builtin_amdgcn_sched_barrier(0);
    }
    if (V_FP4) {
#pragma unroll
      for (int j = 0; j < 8; j++) { acc[2 * j] = acc2[j][0]; acc[2 * j + 1] = acc2[j][1]; }
    }
    float xv[16];
    load_row16<true>(p.xmid + (size_t)t * DM, lane, xv);
    const float* m = p.mod + ((size_t)l * 5 + cond_of(t)) * 6144 + 5120 + lane * 16;
#pragma unroll
    for (int q = 0; q < 4; q++) {
      const float4 g = *(const float4*)(m + 4 * q);
      xv[4 * q] += g.x * acc[4 * q]; xv[4 * q + 1] += g.y * acc[4 * q + 1];
      xv[4 * q + 2] += g.z * acc[4 * q + 2]; xv[4 * q + 3] += g.w * acc[4 * q + 3];
    }
    if (l == 0) {
#pragma unroll
      for (int q = 0; q < 4; q++)
        *(float4*)(p.x + (size_t)t * DM + lane * 16 + 4 * q) = make_float4(xv[4 * q], xv[4 * q + 1], xv[4 * q + 2], xv[4 * q + 3]);
      const float* m1 = p.mod + ((size_t)1 * 5 + cond_of(t)) * 6144;
      norm_emit<true>(xv, lane, p.in[9] + DM, m1 + 1024, m1, p.h, t, nullptr);
    } else {
      norm_emit<true>(xv, lane, p.in[32], nullptr, nullptr, nullptr, 0, p.out + (size_t)t * DM);
    }
  }
}

template <int S>
__device__ __forceinline__ void run_stage(const Params& p, int l, char* smem, const Blk& bk) {
  if (S == 0) ph_prologue(p, smem);
  else if (S == 1) ph_norm(p, 0, 0);
  else if (S == 2) ph_gemm_in(p, l, smem, bk);
  else if (S == 3) ph_mixers(p, l, smem);
  else if (S == 4) ph_attn(p, l, smem);
  else if (S == 5) ph_merge(p, l, smem, bk);
  else if (S == 6) ph_out(p, l, smem, bk);
  else if (S == 7) ph_norm(p, l, 1);
  else if (S == 8) ph_peer_q(p, l, smem, bk);
  else if (S == 9) ph_route(p, l, smem);
  else if (S == 10) ph_gather(p, l, smem);
}

template <int S>
__global__ void __launch_bounds__(256, 2) k_stage(Params p, int l) {
  __shared__ __align__(16) char smem[SMEM_BYTES];
  Blk bk; bk.xcd = blockIdx.x & 7; bk.rank = blockIdx.x >> 3; bk.nblk = gridDim.x >> 3;
  run_stage<S>(p, l, smem, bk);
}

__device__ __forceinline__ unsigned at_ld(unsigned* p) { return __hip_atomic_load(p, __ATOMIC_RELAXED, __HIP_MEMORY_SCOPE_AGENT); }
__device__ __forceinline__ unsigned at_add(unsigned* p, unsigned v) { return __hip_atomic_fetch_add(p, v, __ATOMIC_RELAXED, __HIP_MEMORY_SCOPE_AGENT); }
__device__ __forceinline__ void gbar(unsigned* base, int xcd, unsigned nblk_x, unsigned k, bool phys = false) {
  asm volatile("s_waitcnt vmcnt(0)" ::: "memory");
  __syncthreads();
  if (threadIdx.x == 0) {
    if (!phys) {
      __builtin_amdgcn_fence(__ATOMIC_RELEASE, "agent");
      asm volatile("s_waitcnt vmcnt(0)" ::: "memory");
    }
    unsigned* xarr = base + 64 * (1 + xcd);
    unsigned* xgen = base + 64 * (9 + xcd);
    const unsigned prev = at_add(xarr, 1u);
    if (prev == k * nblk_x - 1u) {
      if (phys) {
        __builtin_amdgcn_fence(__ATOMIC_RELEASE, "agent");
        asm volatile("s_waitcnt vmcnt(0)" ::: "memory");
      }
      at_add(base, 1u);
      while (at_ld(base) < 8u * k) __builtin_amdgcn_s_sleep(1);
      __hip_atomic_store(xgen, k, __ATOMIC_RELAXED, __HIP_MEMORY_SCOPE_AGENT);
    } else {
      while (at_ld(xgen) < k) __builtin_amdgcn_s_sleep(2);
    }
    __builtin_amdgcn_fence(__ATOMIC_ACQUIRE, "agent");
    asm volatile("s_waitcnt vmcnt(0)" ::: "memory");
  }
  __syncthreads();
}
#define STAGE(S, L) for (int r_ = 0; r_ < p.reps[S]; r_++) { run_stage<S>(p, L, smem, bk); epoch += 1; gbar(bctr, bk.xcd, (unsigned)bk.nblk, epoch, phys); }
template <int L>
__device__ __forceinline__ void run_layer(const Params& p, char* smem, unsigned* bctr, unsigned& epoch, const Blk& bk, const bool phys) {
  STAGE(2, L) STAGE(3, L) STAGE(4, L) STAGE(5, L) STAGE(6, L) STAGE(7, L) STAGE(8, L) STAGE(9, L) STAGE(10, L)
}
__global__ void __launch_bounds__(256, 2) mega(Params p) {
  __shared__ __align__(16) char smem[SMEM_BYTES];
  cg::grid_group grid = cg::this_grid();
  Blk bk;
  {
    int* sI = (int*)smem;
    if (threadIdx.x == 0) {
      const int x = (int)(__builtin_amdgcn_s_getreg((3 << 11) | 20) & 7u);
      sI[0] = x;
      sI[1] = atomicAdd(&p.xcnt[x], 1);
    }
    __syncthreads();
    bk.xcd = __builtin_amdgcn_readfirstlane(sI[0]);
    bk.rank = __builtin_amdgcn_readfirstlane(sI[1]);
    bk.nblk = 0;
    __syncthreads();
  }
  unsigned* bctr = (unsigned*)p.xcnt + 64;
  unsigned epoch = 0;
  bool phys = false;
  {
    const Blk bk0 = {0, 0, 1};
    run_stage<0>(p, 0, smem, bk0);
    if (p.reps[11] < 0) grid.sync();
    gbar(bctr + 64 * 40, (int)(blockIdx.x & 7), gridDim.x >> 3, 1u);
  }
  {
    int mine = 0, mn = 1 << 30, tot = 0;
#pragma unroll
    for (int x = 0; x < 8; x++) {
      const int c = __hip_atomic_load(&p.xcnt[x], __ATOMIC_RELAXED, __HIP_MEMORY_SCOPE_AGENT);
      mine = (x == bk.xcd) ? c : mine;
      mn = c < mn ? c : mn;
      tot += c;
    }
    phys = mn > 0 && tot == (int)gridDim.x;
    if (phys) bk.nblk = mine;
    else { bk.xcd = blockIdx.x & 7; bk.rank = blockIdx.x >> 3; bk.nblk = gridDim.x >> 3; }
  }
  STAGE(1, 0)
  run_layer<0>(p, smem, bctr, epoch, bk, phys);
  run_layer<1>(p, smem, bctr, epoch, bk, phys);
}

extern "C" void kernel_launch(void* const* d_in, const int* in_sizes, int n_in, void* d_out, int out_size, void* d_ws,
                              size_t ws_size, hipStream_t stream) {
  Params p;
  memset(&p, 0, sizeof(p));
  for (int i = 0; i < 33; i++) p.in[i] = (const float*)d_in[i];
  p.out = (float*)d_out;
  char* w = (char*)d_ws;
  size_t off = 0;
  auto alloc = [&](size_t bytes) { char* r = w + off; off += (bytes + 255) & ~(size_t)255; return r; };
  p.WtIn = (u16*)alloc((size_t)2 * INW * 1024 * 2);
  p.WtUpA = (u16*)alloc((size_t)2 * 524288 * 2);
  p.WtUpB = (u16*)alloc((size_t)2 * 524288 * 2);
  p.WtUpC = (u16*)alloc((size_t)2 * 524288 * 2);
  p.WtOut = (u16*)alloc((size_t)2 * 1048576 * 2);
  p.WtQ = (u16*)alloc((size_t)2 * 2097152 * 2);
  p.KeysB = (u16*)alloc((size_t)2 * 32768 * 2);
  p.AwsB = (u16*)alloc((size_t)2 * 65536 * 2);
  p.LruWt = (u16*)alloc((size_t)2 * 131072 * 2);
  p.PU = (u16*)alloc((size_t)2 * 16384 * 1024);
  p.PV = (u16*)alloc((size_t)2 * 16384 * 1024);
  p.mod = (float*)alloc((size_t)2 * 5 * 6144 * 4);
  p.rope = (float*)alloc((size_t)3072 * 4);
  p.lam = (float*)alloc(256);
  p.x = (float*)alloc((size_t)T_ALL * DM * 4);
  p.h = (u16*)alloc((size_t)T_ALL * DM * 2);
  p.proj = (u16*)alloc((size_t)T_ALL * INW * 2);
  p.hs = (u16*)alloc((size_t)2 * T_ALL * 512 * 2);
  p.ya = (u16*)alloc((size_t)T_ALL * 512 * 2);
  p.yc = (u16*)alloc((size_t)T_ALL * 512 * 2);
  p.Qb = (u16*)alloc((size_t)T_ALL * 512 * 2);
  p.Kb = (u16*)alloc((size_t)7340032 * 2);
  p.Vt = (u16*)alloc((size_t)7340032 * 2);
  p.pidx = (int*)alloc((size_t)T_ALL * 128 * 4);
  p.pgate = (float*)alloc((size_t)T_ALL * 128 * 4);
  p.acum = (u16*)alloc((size_t)2 * T_ALL * 512 * 2);
  p.segtot = (float*)alloc((size_t)4 * 2 * 8 * 2 * 512 * 4);
  p.xcnt = (int*)alloc(16384);
  hipMemsetAsync(p.xcnt, 0, 16384, stream);
  p.yb = (u16*)p.pidx;
  p.xmid = (float*)((char*)p.proj + ((size_t)64 << 20));
  { const int reps[12] = {1, 1, 1, 1, 1, 1, 1, 1, 1, 1, 1, 0}; for (int i = 0; i < 12; i++) p.reps[i] = reps[i]; }
  if (off > ws_size) fprintf(stderr, "workspace too small: need %zu have %zu\n", off, ws_size);
  static int grid_blocks = 0;
  if (!grid_blocks) {
    int dev = 0, cus = 0, per_cu = 0;
    hipGetDevice(&dev);
    hipDeviceGetAttribute(&cus, hipDeviceAttributeMultiprocessorCount, dev);
    hipOccupancyMaxActiveBlocksPerMultiprocessor(&per_cu, mega, 256, 0);
    if (per_cu > 2) per_cu = 2;
    grid_blocks = cus * per_cu;
  }
  void* args[] = {&p};
  hipError_t e = hipLaunchCooperativeKernel((void*)mega, dim3(grid_blocks), dim3(256), args, 0, stream);
  if (e != hipSuccess) fprintf(stderr, "cooperative launch failed: %s (grid %d)\n", hipGetErrorString(e), grid_blocks);
}
```
